# Optimizing an MI355X kernel written in HIP

```python
import math
import jax, jax.numpy as jnp
from jax import lax
import numpy as np

D_MODEL = 1024
BATCH = 16
SEQ = 256
DEPTH = 4
DEC_BATCH = 2
DEC_SEQ = 2048
PAST_LEN = 512

GRID_W = 64
N_AB = (DEPTH + 1) // 2
N_C = DEPTH // 2
DIFF_HEADS = 8
DIFF_QK = 32
DIFF_V = 2 * DIFF_QK
DIFF_WIDTH = DIFF_HEADS * DIFF_V
DIFF_QW = DIFF_HEADS * 2 * DIFF_QK
ROPE_PAIRS = DIFF_QK // 4
ROPE_BASE = 10000.0
Q_BLOCK = 128
RWKV_HEADS = 8
RWKV_HS = 64
RWKV_WIDTH = RWKV_HEADS * RWKV_HS
DECAY_LORA = 64
ICL_LORA = 64
GATE_LORA = 128
RWKV_IN = 3 * RWKV_WIDTH + DECAY_LORA + ICL_LORA + GATE_LORA
AB_IN = 2 * DIFF_QW + DIFF_WIDTH + RWKV_IN
AB_OUT = DIFF_WIDTH + RWKV_WIDTH
HYENA_ORDER = 2
BANDS = 16
FILTER_EMB = 1 + 2 * BANDS
FILTER_WIDTH = 64
FILTER_OUT = HYENA_ORDER * 2 * D_MODEL
MAX_DECAY = math.log(1e-2) / 0.3
MIN_DECAY = math.log(1e-2) / 1.5
D_FF = ((8 * D_MODEL // 3 + 255) // 256) * 256
RMS_EPS = 1e-6
GN_EPS = 64e-5

kernel_name = 'hybrid_diffattn_rwkv7_hyena_prefix_dit_step'


def _lambda_init(l):
    return 0.8 - 0.6 * math.exp(-0.3 * l)


def _layer_slice(stack, i):
    return {n: a[i] for n, a in stack.items()}


def _rmsnorm(x, g):
    xf = x.astype(jnp.float32)
    y = xf * lax.rsqrt(jnp.mean(xf * xf, axis=-1, keepdims=True) + RMS_EPS)
    return y.astype(x.dtype) * g


def _ada(cond, w, b):
    m = jax.nn.silu(cond) @ w + b
    return [t[:, None, :] for t in jnp.split(m, 6, axis=-1)]


def _ffn_sub(x, shift, scale, gate, g, w1, w3, w2):
    h = _rmsnorm(x, g) * (1 + scale) + shift
    return x + gate * ((jax.nn.silu(h @ w1) * (h @ w3)) @ w2)


def _axial_rope(L):
    n_rows = L // GRID_W
    row = jnp.repeat(jnp.arange(n_rows, dtype=jnp.float32), GRID_W)
    col = jnp.tile(jnp.arange(GRID_W, dtype=jnp.float32), n_rows)
    inv = ROPE_BASE ** (-jnp.arange(ROPE_PAIRS, dtype=jnp.float32) / ROPE_PAIRS)
    ar = row[:, None] * inv[None]
    ac = col[:, None] * inv[None]
    ang = jnp.concatenate([ar, ar, ac, ac], axis=-1)
    return jnp.cos(ang), jnp.sin(ang)


def _apply_rope(x, cos, sin):
    xs = x.reshape(x.shape[:-1] + (2, 2, ROPE_PAIRS))
    rot = jnp.stack([-xs[..., 1, :], xs[..., 0, :]], axis=-2).reshape(x.shape)
    c = cos.astype(x.dtype)[None, :, None, None, :]
    s = sin.astype(x.dtype)[None, :, None, None, :]
    return x * c + rot * s


def _diff_attend(q, k, v, lam):
    B, H, _, Lq, dq = q.shape
    nblk = Lq // Q_BLOCK
    qb = jnp.moveaxis(q.reshape(B, H, 2, nblk, Q_BLOCK, dq), 3, 0)
    scale = dq ** -0.5

    def one(qi):
        s = jnp.einsum('bhmqd,bhmkd->bhmqk', qi, k).astype(jnp.float32) * scale
        p = jax.nn.softmax(s, axis=-1)
        p = p[:, :, 0] - lam * p[:, :, 1]
        return jnp.einsum('bhqk,bhkd->bhqd', p.astype(v.dtype), v)

    o = lax.map(one, qb)
    return jnp.moveaxis(o, 0, 2).reshape(B, H, Lq, v.shape[-1])


def _head_rms(o, g):
    of = o.astype(jnp.float32)
    y = of * lax.rsqrt(jnp.mean(of * of, axis=-1, keepdims=True) + 1e-5)
    return y.astype(o.dtype) * g


def _center_shift(p, mu):
    prev = jnp.pad(p, ((0, 0), (1, 0), (0, 0)))[:, :-1]
    nxt = jnp.pad(p, ((0, 0), (0, 1), (0, 0)))[:, 1:]
    return p + mu[0] * (prev - p) + mu[1] * (nxt - p)


def _rwkv_scan(r, w, k, v, kk, b, s0, reverse):
    xs = tuple(jnp.moveaxis(t.astype(jnp.float32), 1, 0) for t in (r, w, k, v, kk, b))

    def step(S, inp):
        r_t, w_t, k_t, v_t, kk_t, b_t = inp
        sa = jnp.einsum('bhvk,bhk->bhv', S, -kk_t)
        S = S * w_t[:, :, None, :] + sa[..., None] * b_t[:, :, None, :] + v_t[..., None] * k_t[:, :, None, :]
        return S, jnp.einsum('bhvk,bhk->bhv', S, r_t)

    S, y = lax.scan(step, s0.astype(jnp.float32), xs, reverse=reverse)
    return jnp.moveaxis(y, 0, 1), S


def _rwkv_mix(rw, lp, s0f, s0b):
    B, L, _ = rw.shape
    W = RWKV_WIDTH
    rw = _center_shift(rw, lp['mu'])
    r, k, v = rw[..., :W], rw[..., W:2 * W], rw[..., 2 * W:3 * W]
    o = 3 * W
    wd = rw[..., o:o + DECAY_LORA]
    ad = rw[..., o + DECAY_LORA:o + DECAY_LORA + ICL_LORA]
    gd = rw[..., o + DECAY_LORA + ICL_LORA:]
    g = jax.nn.sigmoid(gd) @ lp['g_up']
    hd = lambda t: t.reshape(B, L, RWKV_HEADS, RWKV_HS)
    kk = hd((k * lp['k_k']).astype(jnp.float32))
    kk = kk / jnp.maximum(jnp.sqrt(jnp.sum(kk * kk, axis=-1, keepdims=True)), 1e-12)
    outs, states = [], []
    for d, s0 in enumerate((s0f, s0b)):
        w = -jax.nn.softplus(-(lp['w0'][d] + jnp.tanh(wd) @ lp['w_up'][d])) - 0.5
        decay = jnp.exp(-jnp.exp(w.astype(jnp.float32)))
        a = jax.nn.sigmoid(lp['a0'][d] + ad @ lp['a_up'][d])
        kd = k * (1 + (a - 1) * lp['k_a'])
        yd, sd = _rwkv_scan(hd(r), hd(decay), hd(kd), hd(v), kk, kk * hd(a).astype(jnp.float32), s0, d == 1)
        bonus = jnp.sum(hd(r) * hd(kd) * lp['r_k'], axis=-1, keepdims=True) * hd(v)
        outs.append(yd + bonus.astype(jnp.float32))
        states.append(sd)
    y = outs[0] + outs[1]
    mu = jnp.mean(y, axis=-1, keepdims=True)
    var = jnp.mean(jnp.square(y - mu), axis=-1, keepdims=True)
    y = ((y - mu) * lax.rsqrt(var + GN_EPS)).reshape(B, L, W).astype(rw.dtype)
    y = (y * lp['ln_g'] + lp['ln_b']) * g
    return y, states[0].astype(rw.dtype), states[1].astype(rw.dtype)


def _ab_mixer(h, lp, lam_init, rope, k_ctx, v_ctx, s0f, s0b):
    B, L, _ = h.shape
    p = h @ lp['w_in']
    q = p[..., :DIFF_QW].reshape(B, L, DIFF_HEADS, 2, DIFF_QK)
    k = p[..., DIFF_QW:2 * DIFF_QW].reshape(B, L, DIFF_HEADS, 2, DIFF_QK)
    v = p[..., 2 * DIFF_QW:2 * DIFF_QW + DIFF_WIDTH].reshape(B, L, DIFF_HEADS, DIFF_V)
    rw = p[..., 2 * DIFF_QW + DIFF_WIDTH:]
    if rope is not None:
        q = _apply_rope(q, rope[0], rope[1])
        k = _apply_rope(k, rope[0], rope[1])
    q = q.transpose(0, 2, 3, 1, 4)
    k = k.transpose(0, 2, 3, 1, 4)
    v = v.transpose(0, 2, 1, 3)
    if k_ctx is None:
        keys, vals = k, v
    else:
        keys = jnp.concatenate([k_ctx, k], axis=3)
        vals = jnp.concatenate([v_ctx, v], axis=2)
    lv = lp['lam'].astype(jnp.float32)
    lam = jnp.exp(jnp.sum(lv[0] * lv[1])) - jnp.exp(jnp.sum(lv[2] * lv[3])) + lam_init
    o = _diff_attend(q, keys, vals, lam)
    o = _head_rms(o, lp['subln_g']) * (1 - lam_init)
    o = o.transpose(0, 2, 1, 3).reshape(B, L, DIFF_WIDTH)
    if s0f is None:
        s0f = jnp.zeros((B, RWKV_HEADS, RWKV_HS, RWKV_HS), jnp.float32)
        s0b = s0f
    r_out, sf, sb = _rwkv_mix(rw, lp, s0f, s0b)
    out = jnp.concatenate([o, r_out], axis=-1) @ lp['w_out']
    return out, k, v, sf, sb


def _short_conv(z, w, b):
    L = z.shape[1]
    zp = jnp.pad(z, ((0, 0), (1, 1), (0, 0)))
    return zp[:, :L] * w[0] + zp[:, 1:L + 1] * w[1] + zp[:, 2:] * w[2] + b


def _hyena_filters(L, lp):
    f32 = jnp.float32
    t = jnp.linspace(0.0, 1.0, L, dtype=f32)[:, None]
    wpos = 2.0 * math.pi * jnp.arange(L, dtype=f32)[:, None] / L
    f = jnp.linspace(1e-4, BANDS - 1, BANDS, dtype=f32)[None]
    z = jnp.concatenate([t, jnp.cos(f * wpos), -jnp.sin(f * wpos)], axis=-1)
    fr = lp['f_freq'].astype(f32)
    hdn = jnp.sin(fr[0] * (z @ lp['f_w0'].astype(f32) + lp['f_b0'].astype(f32)))
    hdn = jnp.sin(fr[1] * (hdn @ lp['f_w1'].astype(f32) + lp['f_b1'].astype(f32)))
    hdn = jnp.sin(fr[2] * (hdn @ lp['f_w2'].astype(f32) + lp['f_b2'].astype(f32)))
    filt = (hdn @ lp['f_w3'].astype(f32)).reshape(L, HYENA_ORDER, 2, D_MODEL)
    deltas = jnp.abs(jnp.linspace(MIN_DECAY, MAX_DECAY, D_MODEL, dtype=f32))
    window = jnp.exp(-t * deltas[None])
    return filt * window[:, None, None, :]


def _bidir_long_conv(u, h_fwd, h_bwd, bias):
    L = u.shape[1]
    kern = jnp.concatenate([h_fwd, jnp.zeros((1, h_fwd.shape[1]), h_fwd.dtype), h_bwd[:0:-1]], axis=0)
    uf32 = u.astype(jnp.float32)
    uf = jnp.fft.rfft(uf32, n=2 * L, axis=1)
    kf = jnp.fft.rfft(kern, axis=0)
    y = jnp.fft.irfft(uf * kf[None], n=2 * L, axis=1)[:, :L]
    return (y + uf32 * bias.astype(jnp.float32)).astype(u.dtype)


def _hyena_mixer(h, lp):
    L = h.shape[1]
    z = _short_conv(h @ lp['w_in'] + lp['b_in'], lp['conv_w'], lp['conv_b'])
    x1, x2, v = jnp.split(z, 3, axis=-1)
    filt = _hyena_filters(L, lp)
    u = x1 * _bidir_long_conv(v, filt[:, 0, 0], filt[:, 0, 1], lp['bias'][0])
    u = x2 * _bidir_long_conv(u, filt[:, 1, 0], filt[:, 1, 1], lp['bias'][1])
    return u @ lp['w_out'] + lp['b_out']


def setup_inputs(seed: int = 0) -> dict:
    key = jax.random.key(seed)
    ks = iter(jax.random.split(key, 64))
    D = D_MODEL

    def nrm(shape, scale):
        return jax.random.normal(next(ks), shape, jnp.float32) * scale

    def unif(shape, lo, hi):
        return jax.random.uniform(next(ks), shape, jnp.float32, lo, hi)

    return {
        'x_prompt': nrm((BATCH, SEQ, D), 1.0),
        'x_sample': nrm((DEC_BATCH, DEC_SEQ, D), 1.0),
        'cache_diff_k': nrm((DEC_BATCH, N_AB, DIFF_HEADS, 2, PAST_LEN, DIFF_QK), 1.0),
        'cache_diff_v': nrm((DEC_BATCH, N_AB, DIFF_HEADS, PAST_LEN, DIFF_V), 1.0),
        'state_rwkv_fwd': nrm((DEC_BATCH, N_AB, RWKV_HEADS, RWKV_HS, RWKV_HS), 0.5),
        'state_rwkv_bwd': nrm((DEC_BATCH, N_AB, RWKV_HEADS, RWKV_HS, RWKV_HS), 0.5),
        'c': nrm((DEC_BATCH, D), 1.0),
        'c_ctx': nrm((D,), 1.0),
        'ada_w': nrm((DEPTH, D, 6 * D), 0.5 * D ** -0.5),
        'ada_b': nrm((DEPTH, 6 * D), 0.02),
        'norm1_g': 1.0 + nrm((DEPTH, D), 0.05),
        'norm2_g': 1.0 + nrm((DEPTH, D), 0.05),
        'ffn_w1': nrm((DEPTH, D, D_FF), D ** -0.5),
        'ffn_w3': nrm((DEPTH, D, D_FF), D ** -0.5),
        'ffn_w2': nrm((DEPTH, D_FF, D), D_FF ** -0.5),
        'final_g': 1.0 + nrm((D,), 0.05),
        'ab_w_in': nrm((N_AB, D, AB_IN), D ** -0.5),
        'ab_w_out': nrm((N_AB, AB_OUT, D), AB_OUT ** -0.5),
        'diff_lambda': nrm((N_AB, 4, DIFF_QK), 0.1),
        'diff_subln_g': 1.0 + nrm((N_AB, DIFF_V), 0.05),
        'rwkv_mu': unif((N_AB, 2, RWKV_IN), 0.0, 0.5),
        'rwkv_w0': unif((N_AB, 2, RWKV_WIDTH), -6.0, 1.0),
        'rwkv_w_up': nrm((N_AB, 2, DECAY_LORA, RWKV_WIDTH), 0.1),
        'rwkv_a0': nrm((N_AB, 2, RWKV_WIDTH), 0.5),
        'rwkv_a_up': nrm((N_AB, 2, ICL_LORA, RWKV_WIDTH), 0.1),
        'rwkv_g_up': nrm((N_AB, GATE_LORA, RWKV_WIDTH), GATE_LORA ** -0.5),
        'rwkv_k_k': 0.85 + nrm((N_AB, RWKV_WIDTH), 0.05),
        'rwkv_k_a': 1.0 + nrm((N_AB, RWKV_WIDTH), 0.05),
        'rwkv_r_k': nrm((N_AB, RWKV_HEADS, RWKV_HS), 0.1),
        'rwkv_ln_g': 1.0 + nrm((N_AB, RWKV_WIDTH), 0.05),
        'rwkv_ln_b': nrm((N_AB, RWKV_WIDTH), 0.02),
        'hy_w_in': nrm((N_C, D, 3 * D), D ** -0.5),
        'hy_b_in': nrm((N_C, 3 * D), 0.02),
        'hy_conv_w': nrm((N_C, 3, 3 * D), 0.5),
        'hy_conv_b': nrm((N_C, 3 * D), 0.02),
        'hy_f_w0': nrm((N_C, FILTER_EMB, FILTER_WIDTH), FILTER_EMB ** -0.5),
        'hy_f_b0': nrm((N_C, FILTER_WIDTH), 0.1),
        'hy_f_w1': nrm((N_C, FILTER_WIDTH, FILTER_WIDTH), FILTER_WIDTH ** -0.5),
        'hy_f_b1': nrm((N_C, FILTER_WIDTH), 0.1),
        'hy_f_w2': nrm((N_C, FILTER_WIDTH, FILTER_WIDTH), FILTER_WIDTH ** -0.5),
        'hy_f_b2': nrm((N_C, FILTER_WIDTH), 0.1),
        'hy_f_w3': nrm((N_C, FILTER_WIDTH, FILTER_OUT), 0.01),
        'hy_f_freq': 1.0 + nrm((N_C, 3, FILTER_WIDTH), 0.1),
        'hy_bias': nrm((N_C, HYENA_ORDER, D), 0.5),
        'hy_w_out': nrm((N_C, D, D), D ** -0.5),
        'hy_b_out': nrm((N_C, D), 0.02),
    }


def reference(x_prompt, x_sample, cache_diff_k, cache_diff_v, state_rwkv_fwd, state_rwkv_bwd, c, c_ctx,
              ada_w, ada_b, norm1_g, norm2_g, ffn_w1, ffn_w3, ffn_w2, final_g,
              ab_w_in, ab_w_out, diff_lambda, diff_subln_g, rwkv_mu, rwkv_w0, rwkv_w_up, rwkv_a0, rwkv_a_up,
              rwkv_g_up, rwkv_k_k, rwkv_k_a, rwkv_r_k, rwkv_ln_g, rwkv_ln_b,
              hy_w_in, hy_b_in, hy_conv_w, hy_conv_b, hy_f_w0, hy_f_b0, hy_f_w1, hy_f_b1, hy_f_w2, hy_f_b2,
              hy_f_w3, hy_f_freq, hy_bias, hy_w_out, hy_b_out):
    ab = dict(w_in=ab_w_in, w_out=ab_w_out, lam=diff_lambda, subln_g=diff_subln_g, mu=rwkv_mu,
              w0=rwkv_w0, w_up=rwkv_w_up, a0=rwkv_a0, a_up=rwkv_a_up, g_up=rwkv_g_up, k_k=rwkv_k_k,
              k_a=rwkv_k_a, r_k=rwkv_r_k, ln_g=rwkv_ln_g, ln_b=rwkv_ln_b)
    hy = dict(w_in=hy_w_in, b_in=hy_b_in, conv_w=hy_conv_w, conv_b=hy_conv_b, f_w0=hy_f_w0, f_b0=hy_f_b0,
              f_w1=hy_f_w1, f_b1=hy_f_b1, f_w2=hy_f_w2, f_b2=hy_f_b2, f_w3=hy_f_w3, f_freq=hy_f_freq,
              bias=hy_bias, w_out=hy_w_out, b_out=hy_b_out)

    x = x_prompt
    new_k, new_v, new_sf, new_sb = [], [], [], []
    for l in range(DEPTH):
        sh1, sc1, gt1, sh2, sc2, gt2 = _ada(c_ctx[None], ada_w[l], ada_b[l])
        h = _rmsnorm(x, norm1_g[l]) * (1 + sc1) + sh1
        if l % 2 == 0:
            out, kc, vc, sf, sb = _ab_mixer(h, _layer_slice(ab, l // 2), _lambda_init(l),
                                            None, None, None, None, None)
            new_k.append(kc)
            new_v.append(vc)
            new_sf.append(sf)
            new_sb.append(sb)
        else:
            out = _hyena_mixer(h, _layer_slice(hy, l // 2))
        x = x + gt1 * out
        x = _ffn_sub(x, sh2, sc2, gt2, norm2_g[l], ffn_w1[l], ffn_w3[l], ffn_w2[l])
    y_prompt = _rmsnorm(x, final_g)
    new_diff_k = jnp.stack(new_k, axis=1)
    new_diff_v = jnp.stack(new_v, axis=1)
    new_rwkv_fwd = jnp.stack(new_sf, axis=1)
    new_rwkv_bwd = jnp.stack(new_sb, axis=1)

    rope = _axial_rope(x_sample.shape[1])
    x = x_sample
    for l in range(DEPTH):
        sh1, sc1, gt1, sh2, sc2, gt2 = _ada(c, ada_w[l], ada_b[l])
        h = _rmsnorm(x, norm1_g[l]) * (1 + sc1) + sh1
        if l % 2 == 0:
            i = l // 2
            out, _, _, _, _ = _ab_mixer(h, _layer_slice(ab, i), _lambda_init(l), rope,
                                        cache_diff_k[:, i], cache_diff_v[:, i],
                                        state_rwkv_fwd[:, i], state_rwkv_bwd[:, i])
        else:
            out = _hyena_mixer(h, _layer_slice(hy, l // 2))
        x = x + gt1 * out
        x = _ffn_sub(x, sh2, sc2, gt2, norm2_g[l], ffn_w1[l], ffn_w3[l], ffn_w2[l])
    y_sample = _rmsnorm(x, final_g)

    return (y_prompt, y_sample, new_diff_k, new_diff_v, new_rwkv_fwd, new_rwkv_bwd)
```

```cpp
#include <hip/hip_runtime.h>
#include <hip/hip_cooperative_groups.h>
#include <cstdio>
#include <cstdint>
#include <cstring>
namespace cg = cooperative_groups;

#ifndef MULTI
#define MULTI 0
#endif

typedef unsigned short u16;
typedef __attribute__((ext_vector_type(8))) short bf16x8;
typedef __attribute__((ext_vector_type(4))) short bf16x4;
typedef __attribute__((ext_vector_type(16))) float f32x16;
typedef __attribute__((ext_vector_type(4))) unsigned u32x4;
typedef __attribute__((ext_vector_type(2))) unsigned u32x2;

#define NT 256
#define LDS_BYTES 67584
#define NPHASE 37

struct Params {
  const float* in[46];
  float* out;
  u16 *wt_abin, *wt_about, *wt_lora, *wt_hyin, *wt_hyout, *wt_13, *wt_2;
  float* X; u16* H;
  float *modp, *mod, *hd, *rope;
  u16 *qb_i, *qb_ii, *kb_i, *kb_ii, *vt_i, *vt_ii;
  float* rw; u16* la; float *dec, *aa; u16* g; float *yl, *zb, *sl, *pt;
  float* pht; u16* act; float2* u1buf; unsigned* bar; u16 *hdb, *w3t, *ft;
};

enum { I_XP=0, I_XS, I_CK, I_CV, I_SF, I_SB, I_C, I_CCTX, I_ADAW, I_ADAB, I_N1G, I_N2G, I_W1, I_W3, I_W2, I_FG,
       I_ABIN, I_ABOUT, I_LAM, I_SUBG, I_MU, I_W0, I_WUP, I_A0, I_AUP, I_GUP, I_KK, I_KA, I_RK, I_LNG, I_LNB,
       I_HYIN, I_HYBIN, I_HYCW, I_HYCB, I_FW0, I_FB0, I_FW1, I_FB1, I_FW2, I_FB2, I_FW3, I_FFREQ, I_HYBIAS, I_HYOUT, I_HYBOUT };

__device__ __forceinline__ int rtid() { int t = threadIdx.x; asm volatile("" : "+v"(t)); return t; }
__device__ __forceinline__ int rbid() { int b = blockIdx.x; asm volatile("" : "+s"(b)); return b; }
__device__ __forceinline__ int vbi() { int t = threadIdx.x; asm volatile("" : "+v"(t)); return __builtin_amdgcn_readfirstlane(t >> 8); }
__device__ __forceinline__ int ltid() { int t = threadIdx.x; asm volatile("" : "+v"(t)); return t & 255; }
__device__ __forceinline__ int lbid() { int b = blockIdx.x; asm volatile("" : "+s"(b)); return b * 2 + vbi(); }
__device__ __forceinline__ int vgrid() { int g = (int)gridDim.x; asm volatile("" : "+s"(g)); return g * 2; }
typedef __bf16 hbf16x2 __attribute__((ext_vector_type(2)));
typedef float f32x2_t __attribute__((ext_vector_type(2)));
__device__ __forceinline__ u16 f2bf(float f) { return __builtin_bit_cast(unsigned short, (__bf16)f); }
__device__ __forceinline__ unsigned f2bf2(float a, float b) { f32x2_t v = {a, b}; return __builtin_bit_cast(unsigned, __builtin_convertvector(v, hbf16x2)); }
__device__ __forceinline__ float bf2f(u16 h) { return __uint_as_float(((unsigned)h) << 16); }
__device__ __forceinline__ float wsum(float v) { for (int o = 32; o > 0; o >>= 1) v += __shfl_xor(v, o); return v; }
__device__ __forceinline__ float sigm(float x) { return 1.f / (1.f + __expf(-x)); }
__device__ __forceinline__ int cnd_of(int row) { return row < 4096 ? 0 : 1 + ((row - 4096) >> 11); }
typedef float f32x2 __attribute__((ext_vector_type(2)));
__device__ __forceinline__ float dppf(float v, int ctrl) { return v; }
#define DPP_ADD(v, ctrl) ((v) + __int_as_float(__builtin_amdgcn_update_dpp(0, __float_as_int(v), (ctrl), 0xF, 0xF, true)))
__device__ __forceinline__ float wsum_fast(float v) {
  v = DPP_ADD(v, 0xB1); v = DPP_ADD(v, 0x4E); v = DPP_ADD(v, 0x141); v = DPP_ADD(v, 0x140);
  v += __shfl_xor(v, 16); v += __shfl_xor(v, 32);
  return v;
}


#define ACC_ROW(r, hh) (((r) & 3) + 8 * ((r) >> 2) + 4 * (hh))
template <bool LORA = false, class Epi>
__device__ void gemm(const u16* __restrict__ A, const u16* __restrict__ Bt, int M, int N, int K, const Epi& epi, char* smem) {
  u16* sA = (u16*)smem; u16* sB = sA + 128 * 72;
  const int tid = ltid(), lane = tid & 63, w = tid >> 6, wm = w >> 1, wn = w & 1, l31 = lane & 31, hh = lane >> 5;
  const int ntm = M / 128, ntn = N / 128, nk = K / 64;
  for (int tile0 = lbid() - vbi(); tile0 < ntm * ntn; tile0 += vgrid()) {
    const bool active = tile0 + vbi() < ntm * ntn;
    const int tile = min(tile0 + vbi(), ntm * ntn - 1);
    const int tm = tile % ntm, tn = tile / ntm;
    int k0 = 0, nkl = nk;
    if (LORA) { if (tn < 8) { k0 = 0; nkl = 1; } else if (tn < 16) { k0 = 1; nkl = 1; } else { k0 = 2; nkl = 2; } }
    const u16* Ag = A + (size_t)(tm * 128) * K + k0 * 64; const u16* Bg = Bt + (size_t)(tn * 128) * K + k0 * 64;
    f32x16 acc[2][2];
#pragma unroll
    for (int i = 0; i < 2; i++)
#pragma unroll
      for (int j = 0; j < 2; j++)
#pragma unroll
        for (int r = 0; r < 16; r++) acc[i][j][r] = 0.f;
    u32x4 ra[4], rb[4], rc[4], rd[4];
    unsigned offs[4];
#pragma unroll
    for (int i = 0; i < 4; i++) { int id = tid + 256 * i, row = id >> 3, kc = id & 7; offs[i] = (unsigned)(row * K + kc * 8); }
#define GLOAD(RA, RB, KT) \
    { const u16* Ak = Ag + (size_t)(KT) * 64; const u16* Bk = Bg + (size_t)(KT) * 64; \
    _Pragma("unroll") for (int i = 0; i < 4; i++) { RA[i] = *(const u32x4*)(Ak + offs[i]); RB[i] = *(const u32x4*)(Bk + offs[i]); } }
#define KSTEP(RA, RB, KTN) \
    _Pragma("unroll") for (int i = 0; i < 4; i++) { int id = tid + 256 * i, row = id >> 3, kc = id & 7; \
      *(u32x4*)(sA + row * 72 + kc * 8) = RA[i]; *(u32x4*)(sB + row * 72 + kc * 8) = RB[i]; } \
    __syncthreads(); \
    if ((KTN) < nkl) { GLOAD(RA, RB, KTN) } \
    _Pragma("unroll 2") for (int kc = 0; kc < 4; kc++) { \
      bf16x8 a0 = *(const bf16x8*)(sA + (wm * 64 + l31) * 72 + kc * 16 + hh * 8); \
      bf16x8 a1 = *(const bf16x8*)(sA + (wm * 64 + 32 + l31) * 72 + kc * 16 + hh * 8); \
      bf16x8 b0 = *(const bf16x8*)(sB + (wn * 64 + l31) * 72 + kc * 16 + hh * 8); \
      bf16x8 b1 = *(const bf16x8*)(sB + (wn * 64 + 32 + l31) * 72 + kc * 16 + hh * 8); \
      acc[0][0] = __builtin_amdgcn_mfma_f32_32x32x16_bf16(a0, b0, acc[0][0], 0, 0, 0); \
      acc[0][1] = __builtin_amdgcn_mfma_f32_32x32x16_bf16(a0, b1, acc[0][1], 0, 0, 0); \
      acc[1][0] = __builtin_amdgcn_mfma_f32_32x32x16_bf16(a1, b0, acc[1][0], 0, 0, 0); \
      acc[1][1] = __builtin_amdgcn_mfma_f32_32x32x16_bf16(a1, b1, acc[1][1], 0, 0, 0); } \
    __syncthreads();
    GLOAD(ra, rb, 0)
    if (nkl > 1) { GLOAD(rc, rd, 1) }
    for (int kt = 0; kt < nkl; kt += 2) {
      KSTEP(ra, rb, kt + 2)
      if (kt + 1 < nkl) { KSTEP(rc, rd, kt + 3) }
    }
#undef GLOAD
#undef KSTEP
    {
      float* T = (float*)smem + w * (64 * 65);
#pragma unroll
      for (int ti = 0; ti < 2; ti++)
#pragma unroll
        for (int tj = 0; tj < 2; tj++)
#pragma unroll
          for (int r = 0; r < 16; r++) T[(ti * 32 + ACC_ROW(r, hh)) * 65 + tj * 32 + l31] = acc[ti][tj][r];
      __syncthreads();
      if (active) epi.run(T, tm * 128 + wm * 64, tn * 128 + wn * 64, lane);
      __syncthreads();
    }
  }
}

template <class E> struct EpiDirect { static constexpr bool value = false; };
template <int NJ, class Epi, bool LORA = false>
__device__ void gemm8(const u16* __restrict__ A, const u16* __restrict__ Bt, int M, int N, int K, const Epi& epi, char* smem) {
  constexpr int BN = NJ * 64, WN = NJ * 32;
  constexpr int STAGE = 256 * 64 + BN * 64;
  u16* s0 = (u16*)smem;
  const int tid = rtid(), lane = tid & 63, w = tid >> 6, wm = w >> 1, wn = w & 1, l31 = lane & 31, hh = lane >> 5;
  const int ntm = M / 256, ntn = N / BN, nk = K / 64;
  const int rgrid = vgrid() >> 1;
  const int sw = (l31 >> 1) & 7;
  const int fa0 = (wm * 64 + l31) * 64, fa1 = fa0 + 32 * 64, fb0 = 256 * 64 + (wn * WN + l31) * 64;
  for (int tile = rbid(); tile < ntm * ntn; tile += rgrid) {
    const int tm = tile % ntm, tn = tile / ntm;
    int k0 = 0, nkl = nk;
    if (LORA) { if (tn < 8) { k0 = 0; nkl = 1; } else if (tn < 16) { k0 = 1; nkl = 1; } else { k0 = 2; nkl = 2; } }
    const u16* Ag = A + (size_t)(tm * 256) * K + k0 * 64; const u16* Bg = Bt + (size_t)(tn * BN) * K + k0 * 64;
    f32x16 acc[2][NJ];
#pragma unroll
    for (int i = 0; i < 2; i++)
#pragma unroll
      for (int j = 0; j < NJ; j++)
#pragma unroll
        for (int r = 0; r < 16; r++) acc[i][j][r] = 0.f;
    unsigned offs[4]; int wofs[4];
#pragma unroll
    for (int i = 0; i < 4; i++) { int id = tid + 512 * i, row = id >> 3, kc = id & 7; offs[i] = (unsigned)(row * K + kc * 8); wofs[i] = row * 64 + ((kc ^ ((row >> 1) & 7)) << 3); }
    u32x4 ra[4], rb[NJ];
#define GLOAD8(KT) \
    { const u16* Ak = Ag + (size_t)(KT) * 64; const u16* Bk = Bg + (size_t)(KT) * 64; \
    _Pragma("unroll") for (int i = 0; i < 4; i++) ra[i] = *(const u32x4*)(Ak + offs[i]); \
    _Pragma("unroll") for (int i = 0; i < NJ; i++) rb[i] = *(const u32x4*)(Bk + offs[i]); }
#define LSTORE8(ST) \
    { _Pragma("unroll") for (int i = 0; i < 4; i++) *(u32x4*)((ST) + wofs[i]) = ra[i]; \
      _Pragma("unroll") for (int i = 0; i < NJ; i++) *(u32x4*)((ST) + 256 * 64 + wofs[i]) = rb[i]; }
    GLOAD8(0)
    __syncthreads();
    LSTORE8(s0)
    if (nkl > 1) { GLOAD8(1) }
    __syncthreads();
    for (int kt = 0; kt < nkl; kt++) {
      const u16* cur = s0 + (kt & 1) * STAGE;
      if (kt + 1 < nkl) {
        u16* nxt = s0 + ((kt + 1) & 1) * STAGE;
        LSTORE8(nxt)
        if (kt + 2 < nkl) { GLOAD8(kt + 2) }
      }
#pragma unroll 1
      for (int kc = 0; kc < 4; kc++) {
        const int co = (((kc * 2 + hh) ^ sw) << 3);
        bf16x8 a0 = *(const bf16x8*)(cur + fa0 + co);
        bf16x8 a1 = *(const bf16x8*)(cur + fa1 + co);
        bf16x8 bq[NJ];
#pragma unroll
        for (int j = 0; j < NJ; j++) bq[j] = *(const bf16x8*)(cur + fb0 + j * 32 * 64 + co);
        __builtin_amdgcn_s_setprio(1);
#pragma unroll
        for (int j = 0; j < NJ; j++) {
          acc[0][j] = __builtin_amdgcn_mfma_f32_32x32x16_bf16(a0, bq[j], acc[0][j], 0, 0, 0);
          acc[1][j] = __builtin_amdgcn_mfma_f32_32x32x16_bf16(a1, bq[j], acc[1][j], 0, 0, 0);
        }
        __builtin_amdgcn_s_setprio(0);
      }
      __syncthreads();
    }
#undef GLOAD8
#undef LSTORE8
    if constexpr (EpiDirect<Epi>::value) {
#pragma unroll
      for (int jp = 0; jp < NJ / 2; jp++)
#pragma unroll
        for (int ti = 0; ti < 2; ti++) epi.direct(acc[ti][jp * 2], acc[ti][jp * 2 + 1], tm * 256 + wm * 64 + ti * 32, tn * BN + wn * WN + jp * 64, lane);
    } else {
      float* T = (float*)smem + w * (64 * 65);
#pragma unroll
      for (int jp = 0; jp < NJ / 2; jp++) {
#pragma unroll
        for (int ti = 0; ti < 2; ti++)
#pragma unroll
          for (int tj = 0; tj < 2; tj++)
#pragma unroll
            for (int r = 0; r < 16; r++) T[(ti * 32 + ACC_ROW(r, hh)) * 65 + tj * 32 + l31] = acc[ti][jp * 2 + tj][r];
        __syncthreads();
        epi.run(T, tm * 256 + wm * 64, tn * BN + wn * WN + jp * 64, lane);
        __syncthreads();
      }
    }
  }
}

struct EpiAbIn {
  const Params& p; int i;
  __device__ void run(const float* T, int row0, int col0, int lane) const {
    const int grp = row0 >= 4096;
    const int seq = grp ? ((row0 - 4096) >> 11) : (row0 >> 8);
    const int tb = grp ? ((row0 - 4096) & 2047) : (row0 & 255);
    if (col0 < 1024) {
      const int isk = col0 >= 512;
      const int head = (col0 & 511) >> 6;
      const int m = lane >> 5, d = lane & 31;
      const int Lx = grp ? (isk ? 2560 : 2048) : 256;
      u16* base = isk ? (grp ? p.kb_ii : p.kb_i) : (grp ? p.qb_ii : p.qb_i);
      base += ((size_t)((seq * 8 + head) * 2 + m) * Lx + (grp && isk ? 512 : 0) + tb) * 32 + d;
      float* ob = p.out + 8388608 + ((size_t)((((seq * 2 + i) * 8 + head) * 2 + m) * 256 + tb)) * 32 + d;
      const float* rp = p.rope + ((size_t)tb * 16 + ((d >> 4) * 8 + (d & 7))) * 2;
      const float sgn = (d & 8) ? 1.f : -1.f;
#pragma unroll 8
      for (int rr = 0; rr < 64; rr++) {
        float val = T[rr * 65 + lane];
        if (grp) {
          float partner = T[rr * 65 + (lane ^ 8)];
          float c = rp[rr * 32], s = rp[rr * 32 + 1];
          val = val * c + sgn * partner * s;
        }
        base[rr * 32] = f2bf(val);
        if (isk && !grp) ob[rr * 32] = val;
      }
    } else if (col0 < 1536) {
      const int head = (col0 - 1024) >> 6;
      if (!grp) {
        float* ob = p.out + 12582912 + ((size_t)(((seq * 2 + i) * 8 + head) * 256 + tb)) * 64 + lane;
#pragma unroll 4
        for (int rr = 0; rr < 64; rr++) ob[rr * 64] = T[rr * 65 + lane];
      }
      const int Lk = grp ? 2560 : 256;
      u16* vb = (grp ? p.vt_ii : p.vt_i) + ((size_t)((seq * 8 + head) * 64)) * Lk + (grp ? 512 : 0) + tb + lane;
#pragma unroll 4
      for (int dv = 0; dv < 64; dv++) vb[(size_t)dv * Lk] = f2bf(T[lane * 65 + dv]);
    } else {
      float* rb = p.rw + (size_t)row0 * 1792 + (col0 - 1536) + lane;
#pragma unroll 4
      for (int rr = 0; rr < 64; rr++) rb[(size_t)rr * 1792] = T[rr * 65 + lane];
    }
  }
};

struct EpiLora {
  const Params& p; int i;
  __device__ void run(const float* T, int row0, int col0, int lane) const {
    const int col = col0 + lane;
    if (col0 < 1024) {
      const float w0 = p.in[I_W0][i * 1024 + col];
      float* db = p.dec + (size_t)row0 * 1024 + col;
#pragma unroll 2
      for (int rr = 0; rr < 64; rr++) {
        float x = w0 + T[rr * 65 + lane];
        float z = -x;
        float sp = z > 20.f ? z : __logf(1.f + __expf(z));
        float wv = -sp - 0.5f;
        db[(size_t)rr * 1024] = __expf(-__expf(wv));
      }
    } else if (col0 < 2048) {
      const float a0 = p.in[I_A0][i * 1024 + (col - 1024)];
      float* ab = p.aa + (size_t)row0 * 1024 + (col - 1024);
#pragma unroll 4
      for (int rr = 0; rr < 64; rr++) ab[(size_t)rr * 1024] = sigm(a0 + T[rr * 65 + lane]);
    } else {
      u16* gb = p.g + (size_t)row0 * 512 + (col - 2048);
#pragma unroll 4
      for (int rr = 0; rr < 64; rr++) gb[(size_t)rr * 512] = f2bf(T[rr * 65 + lane]);
    }
  }
};

struct EpiResid {
  float* X; const float* gate; const float* bias;
  __device__ void run(const float* T, int row0, int col0, int lane) const {
    const int cnd = cnd_of(row0);
    const int col = col0 + lane;
    const float gt = gate[cnd * 6144 + col];
    const float bs = bias ? bias[col] : 0.f;
    float* xb = X + (size_t)row0 * 1024 + col;
#pragma unroll 1
    for (int r0 = 0; r0 < 64; r0 += 16) {
      float xv[16];
#pragma unroll
      for (int k = 0; k < 16; k++) xv[k] = xb[(size_t)(r0 + k) * 1024];
#pragma unroll
      for (int k = 0; k < 16; k++) xb[(size_t)(r0 + k) * 1024] = xv[k] + gt * (T[(r0 + k) * 65 + lane] + bs);
    }
  }
};

struct EpiSwiglu {
  u16* act;
  __device__ __forceinline__ void direct(const f32x16& a, const f32x16& b, int row0, int col0, int lane) const {
    const int l31 = lane & 31, hh = lane >> 5;
    u16* ab = act + (size_t)row0 * 2816 + (col0 >> 1) + l31;
#pragma unroll
    for (int r = 0; r < 16; r++) {
      const float av = a[r], bv = b[r];
      ab[(size_t)ACC_ROW(r, hh) * 2816] = f2bf(av * sigm(av) * bv);
    }
  }
  __device__ void run(const float* T, int row0, int col0, int lane) const {
    const int c = lane & 31, ro = lane >> 5;
    u16* ab = act + (size_t)(row0 + ro) * 2816 + (col0 >> 1) + c;
#pragma unroll 4
    for (int it = 0; it < 32; it++) {
      const int rr = 2 * it + ro;
      float a = T[rr * 65 + c], b = T[rr * 65 + 32 + c];
      ab[(size_t)(2 * it) * 2816] = f2bf(a * sigm(a) * b);
    }
  }
};

template <> struct EpiDirect<EpiSwiglu> { static constexpr bool value = true; };

struct EpiHyIn {
  u16* pht; const float* bin;
  __device__ void run(const float* T, int row0, int col0, int lane) const {
    u16* pb = pht + (size_t)row0 * 8192 + col0 + lane;
#pragma unroll 4
    for (int rr = 0; rr < 64; rr++) pb[(size_t)rr * 8192] = f2bf(T[rr * 65 + lane] + bin[row0 + rr]);
  }
};

struct EpiFilt {
  u16* ft;
  __device__ void run(const float* T, int row0, int col0, int lane) const {
    const int pidx = col0 + lane;
    const float tn = pidx < 256 ? (float)pidx * (1.f / 255.f) : (float)(pidx - 256) * (1.f / 2047.f);
    const float MINd = -3.0701134573253944f, MAXd = -15.350567286626973f;
    u16* fb = ft + (size_t)row0 * 2304 + pidx;
#pragma unroll 4
    for (int rr = 0; rr < 64; rr++) {
      const int c = (row0 + rr) & 1023;
      const float delta = fabsf(MINd + (MAXd - MINd) * (float)c / 1023.f);
      fb[(size_t)rr * 2304] = f2bf(T[rr * 65 + lane] * __expf(-tn * delta));
    }
  }
};

__device__ void convT(const float* __restrict__ src, int K, int N, u16* __restrict__ dst, int ldd, int koff, int grp, int stride, int off, float* sm) {
  const int tid = ltid();
  const int nkt = K / 64, nnt = N / 64, ntot = nkt * nnt;
  const int c = tid & 63, r0 = tid >> 6;
  float v[16];
  int tile0 = lbid() - vbi();
  if (tile0 < ntot) {
    const int tile = min(tile0 + vbi(), ntot - 1); const int kt = tile % nkt, nt = tile / nkt;
#pragma unroll
    for (int i = 0; i < 16; i++) v[i] = src[(size_t)(kt * 64 + r0 + 4 * i) * N + nt * 64 + c];
  }
  for (; tile0 < ntot; tile0 += vgrid()) {
    const int tile = min(tile0 + vbi(), ntot - 1);
    const int kt = tile % nkt, nt = tile / nkt;
#pragma unroll
    for (int i = 0; i < 16; i++) sm[(r0 + 4 * i) * 65 + c] = v[i];
    __syncthreads();
    if (tile0 + vgrid() < ntot) {
      const int tl2 = min(tile0 + vgrid() + vbi(), ntot - 1); const int kt2 = tl2 % nkt, nt2 = tl2 / nkt;
#pragma unroll
      for (int i = 0; i < 16; i++) v[i] = src[(size_t)(kt2 * 64 + r0 + 4 * i) * N + nt2 * 64 + c];
    }
#pragma unroll
    for (int i = 0; i < 2; i++) {
      const int nl = (tid >> 3) + 32 * i, kc = tid & 7;
      bf16x8 pk;
#pragma unroll
      for (int j = 0; j < 8; j++) pk[j] = (short)f2bf(sm[(kc * 8 + j) * 65 + nl]);
      const int n = nt * 64 + nl;
      const int drow = (n / grp) * stride + off + (n % grp);
      *(bf16x8*)(dst + (size_t)drow * ldd + koff + kt * 64 + kc * 8) = pk;
    }
    __syncthreads();
  }
}

__device__ void phase0(const Params& p, char* smem) {
  float* sm = (float*)smem;
  const int tid = ltid(), lane = tid & 63, w = tid >> 6;
  const int gtid = lbid() * NT + tid, gsz = vgrid() * NT;
  for (int item0 = lbid() - vbi(); item0 < 384; item0 += vgrid()) {
    const int item = min(item0 + vbi(), 383);
    const int l = item / 96, kc = (item / 6) % 16, nb = item % 6;
    if (tid < 192) {
      int cnd = tid >> 6, kk = tid & 63, k = kc * 64 + kk;
      float x = cnd == 0 ? p.in[I_CCTX][k] : p.in[I_C][(cnd - 1) * 1024 + k];
      sm[tid] = x * sigm(x);
    }
    __syncthreads();
    const int n4 = nb * 256 + tid;
    const float4* W = (const float4*)(p.in[I_ADAW] + (size_t)(l * 1024 + kc * 64) * 6144) + n4;
    float4 a0 = {0, 0, 0, 0}, a1 = a0, a2 = a0;
#pragma unroll 16
    for (int kk = 0; kk < 64; kk++) {
      float4 wv = W[(size_t)kk * 1536];
      float s0 = sm[kk], s1 = sm[64 + kk], s2 = sm[128 + kk];
      a0.x += s0 * wv.x; a0.y += s0 * wv.y; a0.z += s0 * wv.z; a0.w += s0 * wv.w;
      a1.x += s1 * wv.x; a1.y += s1 * wv.y; a1.z += s1 * wv.z; a1.w += s1 * wv.w;
      a2.x += s2 * wv.x; a2.y += s2 * wv.y; a2.z += s2 * wv.z; a2.w += s2 * wv.w;
    }
    float* mp = p.modp + ((size_t)(kc * 4 + l) * 3) * 6144 + n4 * 4;
    *(float4*)(mp) = a0; *(float4*)(mp + 6144) = a1; *(float4*)(mp + 12288) = a2;
    __syncthreads();
  }
  for (int i = 0; i < 2; i++) {
    convT(p.in[I_ABIN] + (size_t)i * 1024 * 3328, 1024, 3328, p.wt_abin + (size_t)i * 3328 * 1024, 1024, 0, 3328, 0, 0, sm);
    convT(p.in[I_ABOUT] + (size_t)i * 1024 * 1024, 1024, 1024, p.wt_about + (size_t)i * 1024 * 1024, 1024, 0, 1024, 0, 0, sm);
    convT(p.in[I_HYIN] + (size_t)i * 1024 * 3072, 1024, 3072, p.wt_hyin + (size_t)i * 3072 * 1024, 1024, 0, 3072, 0, 0, sm);
    convT(p.in[I_HYOUT] + (size_t)i * 1024 * 1024, 1024, 1024, p.wt_hyout + (size_t)i * 1024 * 1024, 1024, 0, 1024, 0, 0, sm);
  }
  for (int jl = 0; jl < 2; jl++) convT(p.in[I_FW3] + (size_t)jl * 64 * 4096, 64, 4096, p.w3t + (size_t)jl * 4096 * 64, 64, 0, 4096, 0, 0, sm);
  for (int l = 0; l < 4; l++) {
    convT(p.in[I_W1] + (size_t)l * 1024 * 2816, 1024, 2816, p.wt_13 + (size_t)l * 5632 * 1024, 1024, 0, 32, 64, 0, sm);
    convT(p.in[I_W3] + (size_t)l * 1024 * 2816, 1024, 2816, p.wt_13 + (size_t)l * 5632 * 1024, 1024, 0, 32, 64, 32, sm);
    convT(p.in[I_W2] + (size_t)l * 2816 * 1024, 2816, 1024, p.wt_2 + (size_t)l * 1024 * 2816, 2816, 0, 1024, 0, 0, sm);
  }
  for (int i = gtid; i < 163840; i += gsz) ((uint4*)p.wt_lora)[i] = make_uint4(0, 0, 0, 0);
  for (int item0 = lbid() - vbi(); item0 < 1152; item0 += vgrid()) {
    const int item = min(item0 + vbi(), 1151);
    const int jl = item / 576, pos = (item % 576) * 4 + w;
    int L, t, sel;
    if (pos < 256) { L = 256; t = pos; sel = 0; } else { L = 2048; t = pos - 256; sel = 1; }
    float* zs = sm + w * 128; float* hs = zs + 64;
    if (lane < 33) {
      float z;
      if (lane == 0) z = (float)t / (float)(L - 1);
      else {
        int b = (lane - 1) & 15;
        float f = 1e-4f + (float)b * ((15.f - 1e-4f) / 15.f);
        float wpos = 6.283185307179586f * (float)t / (float)L;
        float ang = f * wpos;
        z = (lane <= 16) ? cosf(ang) : -sinf(ang);
      }
      zs[lane] = z;
    }
    __syncthreads();
    float acc = p.in[I_FB0][jl * 64 + lane];
    for (int e = 0; e < 33; e++) acc += zs[e] * p.in[I_FW0][(jl * 33 + e) * 64 + lane];
    float h = sinf(p.in[I_FFREQ][(jl * 3 + 0) * 64 + lane] * acc);
    hs[lane] = h;
    __syncthreads();
    acc = p.in[I_FB1][jl * 64 + lane];
    for (int e = 0; e < 64; e++) acc += hs[e] * p.in[I_FW1][(jl * 64 + e) * 64 + lane];
    h = sinf(p.in[I_FFREQ][(jl * 3 + 1) * 64 + lane] * acc);
    __syncthreads();
    hs[lane] = h;
    __syncthreads();
    acc = p.in[I_FB2][jl * 64 + lane];
    for (int e = 0; e < 64; e++) acc += hs[e] * p.in[I_FW2][(jl * 64 + e) * 64 + lane];
    h = sinf(p.in[I_FFREQ][(jl * 3 + 2) * 64 + lane] * acc);
    p.hd[((size_t)(jl * 2 + sel) * 2048 + t) * 64 + lane] = h;
    p.hdb[((size_t)jl * 2304 + pos) * 64 + lane] = f2bf(h);
    __syncthreads();
  }
  for (int i = gtid; i < 2097152; i += gsz) {
    float4 v = i < 1048576 ? ((const float4*)p.in[I_XP])[i] : ((const float4*)p.in[I_XS])[i - 1048576];
    ((float4*)p.X)[i] = v;
  }
  for (int i = gtid; i < 2048 * 16; i += gsz) {
    int t = i >> 4, e = i & 15, axis = e >> 3, pp = e & 7;
    float inv = powf(10000.f, -(float)pp / 8.f);
    float pos = axis ? (float)(t & 63) : (float)(t >> 6);
    float ang = pos * inv;
    p.rope[i * 2] = cosf(ang); p.rope[i * 2 + 1] = sinf(ang);
  }
}

__device__ void phase1(const Params& p, char* smem) {
  float* sm = (float*)smem;
  const int gtid = lbid() * NT + ltid(), gsz = vgrid() * NT;
  for (int idx = gtid; idx < 73728; idx += gsz) {
    int l = idx / 18432, n = idx % 6144;
    float a = p.in[I_ADAB][l * 6144 + n];
    for (int kc = 0; kc < 16; kc++) {
      int cndn = idx % 18432;
      a += p.modp[((size_t)(kc * 4 + l) * 3) * 6144 + cndn];
    }
    p.mod[idx] = a;
  }
  for (int i = 0; i < 2; i++) {
    u16* wl = p.wt_lora + (size_t)i * 2560 * 256;
    for (int d = 0; d < 2; d++) {
      convT(p.in[I_WUP] + (size_t)(i * 2 + d) * 64 * 512, 64, 512, wl + (size_t)(d * 512) * 256, 256, 0, 512, 0, 0, sm);
      convT(p.in[I_AUP] + (size_t)(i * 2 + d) * 64 * 512, 64, 512, wl + (size_t)(1024 + d * 512) * 256, 256, 64, 512, 0, 0, sm);
    }
    convT(p.in[I_GUP] + (size_t)i * 128 * 512, 128, 512, wl + (size_t)2048 * 256, 256, 128, 512, 0, 0, sm);
  }
}

__device__ __forceinline__ void norm_out(const Params& p, int row, const float4 (&v)[4], float ss, int lane, const float* g, const float* modl, int shc, int scc) {
  const float rs = rsqrtf(ss * (1.f / 1024.f) + 1e-6f);
  const int cnd = cnd_of(row);
  const float* sh = modl + cnd * 6144 + shc * 1024; const float* sc = modl + cnd * 6144 + scc * 1024;
#pragma unroll
  for (int i = 0; i < 4; i++) {
    const int c = (lane + 64 * i) * 4;
    float4 gg = *(const float4*)(g + c), s1 = *(const float4*)(sc + c), s0 = *(const float4*)(sh + c);
    u32x2 o = {f2bf2(v[i].x * rs * gg.x * (1.f + s1.x) + s0.x, v[i].y * rs * gg.y * (1.f + s1.y) + s0.y),
               f2bf2(v[i].z * rs * gg.z * (1.f + s1.z) + s0.z, v[i].w * rs * gg.w * (1.f + s1.w) + s0.w)};
    *(u32x2*)(p.H + (size_t)row * 1024 + c) = o;
  }
}
__device__ void phase_norm(const Params& p, const float* g, const float* modl, int shc, int scc) {
  const int lane = ltid() & 63, w = ltid() >> 6;
  const int stride = vgrid() * 4;
  for (int row = lbid() * 4 + w; row < 8192; row += 2 * stride) {
    const int rowb = row + stride; const bool hb = rowb < 8192;
    const float4* xa = (const float4*)(p.X + (size_t)row * 1024);
    const float4* xb = (const float4*)(p.X + (size_t)(hb ? rowb : row) * 1024);
    float4 va[4], vb[4]; float sa = 0.f, sb = 0.f;
#pragma unroll
    for (int i = 0; i < 4; i++) { va[i] = xa[lane + 64 * i]; vb[i] = xb[lane + 64 * i]; }
#pragma unroll
    for (int i = 0; i < 4; i++) {
      sa += va[i].x * va[i].x + va[i].y * va[i].y + va[i].z * va[i].z + va[i].w * va[i].w;
      sb += vb[i].x * vb[i].x + vb[i].y * vb[i].y + vb[i].z * vb[i].z + vb[i].w * vb[i].w;
    }
    sa = wsum_fast(sa); sb = wsum_fast(sb);
    norm_out(p, row, va, sa, lane, g, modl, shc, scc);
    if (hb) norm_out(p, rowb, vb, sb, lane, g, modl, shc, scc);
  }
}

__device__ __forceinline__ void final_out(const Params& p, int row, const float4 (&v)[4], float ss, int lane, const float* g) {
  const float rs = rsqrtf(ss * (1.f / 1024.f) + 1e-6f);
#pragma unroll
  for (int i = 0; i < 4; i++) {
    const int c = (lane + 64 * i) * 4;
    float4 gg = *(const float4*)(g + c);
    float4 o = {v[i].x * rs * gg.x, v[i].y * rs * gg.y, v[i].z * rs * gg.z, v[i].w * rs * gg.w};
    *(float4*)(p.out + (size_t)row * 1024 + c) = o;
  }
}
__device__ void phase_final(const Params& p) {
  const int lane = ltid() & 63, w = ltid() >> 6;
  const float* g = p.in[I_FG];
  const int stride = vgrid() * 4;
  for (int row = lbid() * 4 + w; row < 8192; row += 2 * stride) {
    const int rowb = row + stride; const bool hb = rowb < 8192;
    const float4* xa = (const float4*)(p.X + (size_t)row * 1024);
    const float4* xb = (const float4*)(p.X + (size_t)(hb ? rowb : row) * 1024);
    float4 va[4], vb[4]; float sa = 0.f, sb = 0.f;
#pragma unroll
    for (int i = 0; i < 4; i++) { va[i] = xa[lane + 64 * i]; vb[i] = xb[lane + 64 * i]; }
#pragma unroll
    for (int i = 0; i < 4; i++) {
      sa += va[i].x * va[i].x + va[i].y * va[i].y + va[i].z * va[i].z + va[i].w * va[i].w;
      sb += vb[i].x * vb[i].x + vb[i].y * vb[i].y + vb[i].z * vb[i].z + vb[i].w * vb[i].w;
    }
    sa = wsum_fast(sa); sb = wsum_fast(sb);
    final_out(p, row, va, sa, lane, g);
    if (hb) final_out(p, rowb, vb, sb, lane, g);
  }
}

__device__ void cache_conv(const Params& p, int i) {
  const int gtid = lbid() * NT + ltid(), gsz = vgrid() * NT;
#pragma unroll 4
  for (int idx = gtid; idx < 2 * 8 * 2 * 512 * 32; idx += gsz) {
    int e = idx & 16383, bhm = idx >> 14;
    int b = bhm >> 4, hm = bhm & 15;
    float v = p.in[I_CK][((size_t)((b * 2 + i) * 16 + hm)) * 16384 + e];
    p.kb_ii[(size_t)bhm * 2560 * 32 + e] = f2bf(v);
  }
#pragma unroll 4
  for (int idx = gtid; idx < 2 * 8 * 512 * 64; idx += gsz) {
    int dv = idx & 63, key = (idx >> 6) & 511, bh = idx >> 15;
    int b = bh >> 3, h = bh & 7;
    float v = p.in[I_CV][((size_t)((b * 2 + i) * 8 + h) * 512 + key) * 64 + dv];
    p.vt_ii[((size_t)bh * 64 + dv) * 2560 + key] = f2bf(v);
  }
}

__device__ void phase_prep(const Params& p, int i) {
  const int tid = ltid();
  const float* mu = p.in[I_MU] + (size_t)i * 2 * 1792;
  const int f = 1536 + tid;
  const float m0 = mu[f], m1 = mu[1792 + f];
  const int vg = vgrid();
  for (int tok0 = lbid(); tok0 < 8192; tok0 += 8 * vg) {
    float cur[8], prev[8], nxt[8];
#pragma unroll
    for (int k = 0; k < 8; k++) {
      const int tok = tok0 + k * vg;
      cur[k] = 0.f; prev[k] = 0.f; nxt[k] = 0.f;
      if (tok < 8192) {
        int t, L;
        if (tok < 4096) { t = tok & 255; L = 256; } else { t = (tok - 4096) & 2047; L = 2048; }
        const float* rp = p.rw + (size_t)tok * 1792 + f;
        cur[k] = rp[0];
        if (t > 0) prev[k] = rp[-1792];
        if (t < L - 1) nxt[k] = rp[1792];
      }
    }
#pragma unroll
    for (int k = 0; k < 8; k++) {
      const int tok = tok0 + k * vg;
      if (tok < 8192) {
        const float v = cur[k] + m0 * (prev[k] - cur[k]) + m1 * (nxt[k] - cur[k]);
        float o;
        if (tid < 64) o = tanhf(v); else if (tid < 128) o = v; else o = sigm(v);
        p.la[(size_t)tok * 256 + tid] = f2bf(o);
      }
    }
  }
}

struct ScanRaw { float cr[4], ck[4], cv[4], pr[4], pk[4], pv[4], nr[4], nk[4], nv[4], dec[4], a[4]; };

__device__ void scan_unit(const Params& p, int i, int grp, int seq, int h, int dir, int chunk, int kind, char* smem) {
  constexpr int BUF = 6 * 1024 + 32;
  float* sbase = (float*)smem;
  const int tid = ltid(), lane = tid & 63, w = tid >> 6;
  const int rp = tid >> 3, q = tid & 7, v0 = 2 * rp;
  const int L = grp ? 2048 : 256;
  const int tokbase = grp ? 4096 + seq * 2048 : seq * 256;
  const int c = h * 64 + lane;
  const float* mu = p.in[I_MU] + (size_t)i * 2 * 1792;
  const float mr0 = mu[c], mr1 = mu[1792 + c], mk0 = mu[512 + c], mk1 = mu[1792 + 512 + c], mv0 = mu[1024 + c], mv1 = mu[1792 + 1024 + c];
  const float kkw = p.in[I_KK][i * 512 + c], kaw = p.in[I_KA][i * 512 + c], rkw = p.in[I_RK][i * 512 + c];
  f32x2 S0[4], S1[4];
#pragma unroll
  for (int e = 0; e < 4; e++) {
    S0[e].x = (kind == 1 && v0 == q * 8 + 2 * e) ? 1.f : 0.f; S0[e].y = (kind == 1 && v0 == q * 8 + 2 * e + 1) ? 1.f : 0.f;
    S1[e].x = (kind == 1 && v0 + 1 == q * 8 + 2 * e) ? 1.f : 0.f; S1[e].y = (kind == 1 && v0 + 1 == q * 8 + 2 * e + 1) ? 1.f : 0.f;
  }
  ScanRaw R;
  auto stage_load = [&](int sc) {
#pragma unroll
    for (int jj = 0; jj < 4; jj++) {
      const int j = w + 4 * jj;
      const int ps = chunk * 256 + sc * 16 + j;
      const int t = dir ? L - 1 - ps : ps;
      const float* rp = p.rw + (size_t)(tokbase + t) * 1792 + c;
      const bool hp = t > 0, hn = t < L - 1;
      R.cr[jj] = rp[0]; R.ck[jj] = rp[512]; R.cv[jj] = rp[1024];
      R.pr[jj] = hp ? rp[-1792] : 0.f; R.pk[jj] = hp ? rp[-1792 + 512] : 0.f; R.pv[jj] = hp ? rp[-1792 + 1024] : 0.f;
      R.nr[jj] = hn ? rp[1792] : 0.f; R.nk[jj] = hn ? rp[1792 + 512] : 0.f; R.nv[jj] = hn ? rp[1792 + 1024] : 0.f;
      R.dec[jj] = p.dec[(size_t)(tokbase + t) * 1024 + dir * 512 + c];
      R.a[jj] = p.aa[(size_t)(tokbase + t) * 1024 + dir * 512 + c];
    }
  };
  auto stage_finish = [&](float* sb) {
#pragma unroll
    for (int jj = 0; jj < 4; jj++) {
      const int j = w + 4 * jj;
      const float rs = R.cr[jj] + mr0 * (R.pr[jj] - R.cr[jj]) + mr1 * (R.nr[jj] - R.cr[jj]);
      const float ks = R.ck[jj] + mk0 * (R.pk[jj] - R.ck[jj]) + mk1 * (R.nk[jj] - R.ck[jj]);
      const float vs = R.cv[jj] + mv0 * (R.pv[jj] - R.cv[jj]) + mv1 * (R.nv[jj] - R.cv[jj]);
      const float dec = R.dec[jj], a = R.a[jj];
      const float kkr = ks * kkw;
      const float ss = wsum_fast(kkr * kkr);
      const float kk = kkr / fmaxf(sqrtf(ss), 1e-12f);
      const float kd = ks * (1.f + (a - 1.f) * kaw);
      const float bb = kk * a;
      const float bon = wsum_fast(rs * kd * rkw);
      const float br = wsum_fast(bb * rs);
      const float kr = wsum_fast(kd * rs);
      sb[j * 64 + lane] = dec; sb[1024 + j * 64 + lane] = -kk; sb[2048 + j * 64 + lane] = bb; sb[3072 + j * 64 + lane] = kd;
      sb[4096 + j * 64 + lane] = dec * rs; sb[5120 + j * 64 + lane] = kind ? 0.f : vs;
      if (lane == 0) { sb[6144 + j] = br; sb[6160 + j] = kr + bon; }
    }
  };
  stage_load(0);
  __syncthreads();
  stage_finish(sbase);
  __syncthreads();
  for (int sc = 0; sc < 16; sc++) {
    const float* sb = sbase + (sc & 1) * BUF;
    if (sc + 1 < 16) stage_load(sc + 1);
    f32x2 nq[4], rq[4];
    {
      const f32x2* n2 = (const f32x2*)(sb + 1024 + q * 8); const f32x2* r2 = (const f32x2*)(sb + 4096 + q * 8);
#pragma unroll
      for (int e = 0; e < 4; e++) { nq[e] = n2[e]; rq[e] = r2[e]; }
    }
#pragma unroll 2
    for (int j = 0; j < 16; j++) {
      const int ps = chunk * 256 + sc * 16 + j;
      const int t = dir ? L - 1 - ps : ps;
      const int tok = tokbase + t;
      const int jn = (j + 1) & 15;
      const f32x2* w2 = (const f32x2*)(sb + j * 64 + q * 8);
      const f32x2* n2x = (const f32x2*)(sb + 1024 + jn * 64 + q * 8);
      const f32x2* b2 = (const f32x2*)(sb + 2048 + j * 64 + q * 8);
      const f32x2* k2 = (const f32x2*)(sb + 3072 + j * 64 + q * 8);
      const f32x2* r2x = (const f32x2*)(sb + 4096 + jn * 64 + q * 8);
      const f32x2 vvp = *(const f32x2*)(sb + 5120 + j * 64 + v0);
      const float br = sb[6144 + j], c2 = sb[6160 + j];
      f32x2 nx[4], rx[4];
#pragma unroll
      for (int e = 0; e < 4; e++) { nx[e] = n2x[e]; rx[e] = r2x[e]; }
      f32x2 sa0 = {0.f, 0.f}, y0 = {0.f, 0.f}, sa1 = {0.f, 0.f}, y1 = {0.f, 0.f};
#pragma unroll
      for (int e = 0; e < 4; e++) { const f32x2 nn = nq[e], rr = rq[e]; sa0 += S0[e] * nn; y0 += S0[e] * rr; sa1 += S1[e] * nn; y1 += S1[e] * rr; }
#pragma unroll
      for (int e = 0; e < 4; e++) { nq[e] = nx[e]; rq[e] = rx[e]; }
      float a0 = sa0.x + sa0.y, a1 = sa1.x + sa1.y, z0 = y0.x + y0.y, z1 = y1.x + y1.y;
      a0 = DPP_ADD(a0, 0xB1); a1 = DPP_ADD(a1, 0xB1); z0 = DPP_ADD(z0, 0xB1); z1 = DPP_ADD(z1, 0xB1);
      a0 = DPP_ADD(a0, 0x4E); a1 = DPP_ADD(a1, 0x4E); z0 = DPP_ADD(z0, 0x4E); z1 = DPP_ADD(z1, 0x4E);
      a0 = DPP_ADD(a0, 0x141); a1 = DPP_ADD(a1, 0x141); z0 = DPP_ADD(z0, 0x141); z1 = DPP_ADD(z1, 0x141);
      const f32x2 sav0 = {a0, a0}, sav1 = {a1, a1}, vv0 = {vvp.x, vvp.x}, vv1 = {vvp.y, vvp.y};
#pragma unroll
      for (int e = 0; e < 4; e++) {
        const f32x2 ww = w2[e], bb = b2[e], kk = k2[e];
        S0[e] = S0[e] * ww + sav0 * bb + vv0 * kk;
        S1[e] = S1[e] * ww + sav1 * bb + vv1 * kk;
      }
      if (q == 0) {
        f32x2 yo = {z0 + a0 * br + vvp.x * c2, z1 + a1 * br + vvp.y * c2};
        if (kind == 0) *(f32x2*)(p.yl + ((size_t)dir * 8192 + tok) * 512 + h * 64 + v0) = yo;
        else *(f32x2*)(p.zb + ((size_t)dir * 4096 + (tok - 4096)) * 512 + h * 64 + v0) = yo;
      }
    }
    if (sc + 1 < 16) stage_finish(sbase + ((sc + 1) & 1) * BUF);
    asm volatile("s_waitcnt lgkmcnt(0)\n\ts_barrier" ::: "memory");
  }
  float* dst;
  if (grp == 0) dst = p.out + (dir ? 17825792 : 16777216) + ((size_t)((seq * 2 + i) * 8 + h)) * 4096;
  else {
    const int u = ((seq * 8 + h) * 2 + dir) * 8 + chunk;
    dst = (kind ? p.pt : p.sl) + (size_t)u * 4096;
  }
#pragma unroll
  for (int e = 0; e < 2; e++) {
    *(float4*)(dst + v0 * 64 + q * 8 + 4 * e) = make_float4(S0[2 * e].x, S0[2 * e].y, S0[2 * e + 1].x, S0[2 * e + 1].y);
    *(float4*)(dst + (v0 + 1) * 64 + q * 8 + 4 * e) = make_float4(S1[2 * e].x, S1[2 * e].y, S1[2 * e + 1].x, S1[2 * e + 1].y);
  }
}

__device__ void scan_unit2(const Params& p, int i, int seq, int h, int dir, int chunk, char* smem) {
  const int grp = 1; const int kind = 0;
  constexpr int BUF = 6 * 1024 + 32;
  float* sbase = (float*)smem;
  const int tid = ltid(), lane = tid & 63, w = tid >> 6;
  const int v = tid >> 2, q = tid & 3;
  const int L = grp ? 2048 : 256;
  const int tokbase = grp ? 4096 + seq * 2048 : seq * 256;
  const int c = h * 64 + lane;
  const float* mu = p.in[I_MU] + (size_t)i * 2 * 1792;
  const float mr0 = mu[c], mr1 = mu[1792 + c], mk0 = mu[512 + c], mk1 = mu[1792 + 512 + c], mv0 = mu[1024 + c], mv1 = mu[1792 + 1024 + c];
  const float kkw = p.in[I_KK][i * 512 + c], kaw = p.in[I_KA][i * 512 + c], rkw = p.in[I_RK][i * 512 + c];
  f32x2 S2[8], P2[8];
#pragma unroll
  for (int e = 0; e < 8; e++) { S2[e].x = 0.f; S2[e].y = 0.f; P2[e].x = (v == q * 16 + 2 * e) ? 1.f : 0.f; P2[e].y = (v == q * 16 + 2 * e + 1) ? 1.f : 0.f; }
  ScanRaw R;
  auto stage_load = [&](int sc) {
#pragma unroll
    for (int jj = 0; jj < 4; jj++) {
      const int j = w + 4 * jj;
      const int ps = chunk * 256 + sc * 16 + j;
      const int t = dir ? L - 1 - ps : ps;
      const float* rp = p.rw + (size_t)(tokbase + t) * 1792 + c;
      const bool hp = t > 0, hn = t < L - 1;
      R.cr[jj] = rp[0]; R.ck[jj] = rp[512]; R.cv[jj] = rp[1024];
      R.pr[jj] = hp ? rp[-1792] : 0.f; R.pk[jj] = hp ? rp[-1792 + 512] : 0.f; R.pv[jj] = hp ? rp[-1792 + 1024] : 0.f;
      R.nr[jj] = hn ? rp[1792] : 0.f; R.nk[jj] = hn ? rp[1792 + 512] : 0.f; R.nv[jj] = hn ? rp[1792 + 1024] : 0.f;
      R.dec[jj] = p.dec[(size_t)(tokbase + t) * 1024 + dir * 512 + c];
      R.a[jj] = p.aa[(size_t)(tokbase + t) * 1024 + dir * 512 + c];
    }
  };
  auto stage_finish = [&](float* sb) {
#pragma unroll
    for (int jj = 0; jj < 4; jj++) {
      const int j = w + 4 * jj;
      const float rs = R.cr[jj] + mr0 * (R.pr[jj] - R.cr[jj]) + mr1 * (R.nr[jj] - R.cr[jj]);
      const float ks = R.ck[jj] + mk0 * (R.pk[jj] - R.ck[jj]) + mk1 * (R.nk[jj] - R.ck[jj]);
      const float vs = R.cv[jj] + mv0 * (R.pv[jj] - R.cv[jj]) + mv1 * (R.nv[jj] - R.cv[jj]);
      const float dec = R.dec[jj], a = R.a[jj];
      const float kkr = ks * kkw;
      const float ss = wsum_fast(kkr * kkr);
      const float kk = kkr / fmaxf(sqrtf(ss), 1e-12f);
      const float kd = ks * (1.f + (a - 1.f) * kaw);
      const float bb = kk * a;
      const float bon = wsum_fast(rs * kd * rkw);
      const float br = wsum_fast(bb * rs);
      const float kr = wsum_fast(kd * rs);
      sb[j * 64 + lane] = dec; sb[1024 + j * 64 + lane] = -kk; sb[2048 + j * 64 + lane] = bb; sb[3072 + j * 64 + lane] = kd;
      sb[4096 + j * 64 + lane] = dec * rs; sb[5120 + j * 64 + lane] = kind ? 0.f : vs;
      if (lane == 0) { sb[6144 + j] = br; sb[6160 + j] = kr + bon; }
    }
  };
  stage_load(0);
  __syncthreads();
  stage_finish(sbase);
  __syncthreads();
  for (int sc = 0; sc < 16; sc++) {
    const float* sb = sbase + (sc & 1) * BUF;
    if (sc + 1 < 16) stage_load(sc + 1);
    f32x2 nq[8], rq[8];
    {
      const f32x2* n2 = (const f32x2*)(sb + 1024 + q * 16); const f32x2* r2 = (const f32x2*)(sb + 4096 + q * 16);
#pragma unroll
      for (int e = 0; e < 8; e++) { nq[e] = n2[e]; rq[e] = r2[e]; }
    }
#pragma unroll 2
    for (int j = 0; j < 16; j++) {
      const int ps = chunk * 256 + sc * 16 + j;
      const int t = dir ? L - 1 - ps : ps;
      const int tok = tokbase + t;
      const int jn = (j + 1) & 15;
      const f32x2* w2 = (const f32x2*)(sb + j * 64 + q * 16);
      const f32x2* n2x = (const f32x2*)(sb + 1024 + jn * 64 + q * 16);
      const f32x2* b2 = (const f32x2*)(sb + 2048 + j * 64 + q * 16);
      const f32x2* k2 = (const f32x2*)(sb + 3072 + j * 64 + q * 16);
      const f32x2* r2x = (const f32x2*)(sb + 4096 + jn * 64 + q * 16);
      const float vv = sb[5120 + j * 64 + v];
      const float br = sb[6144 + j], c2 = sb[6160 + j];
      f32x2 nx[8], rx[8];
#pragma unroll
      for (int e = 0; e < 8; e++) { nx[e] = n2x[e]; rx[e] = r2x[e]; }
      f32x2 sas = {0.f, 0.f}, ys = {0.f, 0.f}, sap = {0.f, 0.f}, yp = {0.f, 0.f};
#pragma unroll
      for (int e = 0; e < 8; e++) { const f32x2 nn = nq[e], rr = rq[e]; sas += S2[e] * nn; ys += S2[e] * rr; sap += P2[e] * nn; yp += P2[e] * rr; }
#pragma unroll
      for (int e = 0; e < 8; e++) { nq[e] = nx[e]; rq[e] = rx[e]; }
      float a0 = sas.x + sas.y, a1 = sap.x + sap.y, z0 = ys.x + ys.y, z1 = yp.x + yp.y;
      a0 = DPP_ADD(a0, 0xB1); a1 = DPP_ADD(a1, 0xB1); z0 = DPP_ADD(z0, 0xB1); z1 = DPP_ADD(z1, 0xB1);
      a0 = DPP_ADD(a0, 0x4E); a1 = DPP_ADD(a1, 0x4E); z0 = DPP_ADD(z0, 0x4E); z1 = DPP_ADD(z1, 0x4E);
      const f32x2 sav0 = {a0, a0}, sav1 = {a1, a1}, vvv = {vv, vv};
#pragma unroll
      for (int e = 0; e < 8; e++) {
        const f32x2 ww = w2[e], bb = b2[e], kk = k2[e];
        S2[e] = S2[e] * ww + sav0 * bb + vvv * kk;
        P2[e] = P2[e] * ww + sav1 * bb;
      }
      if (q == 0) {
        p.yl[((size_t)dir * 8192 + tok) * 512 + h * 64 + v] = z0 + a0 * br + vv * c2;
        p.zb[((size_t)dir * 4096 + (tok - 4096)) * 512 + h * 64 + v] = z1 + a1 * br;
      }
    }
    if (sc + 1 < 16) stage_finish(sbase + ((sc + 1) & 1) * BUF);
    asm volatile("s_waitcnt lgkmcnt(0)\n\ts_barrier" ::: "memory");
  }
  {
    const int u = ((seq * 8 + h) * 2 + dir) * 8 + chunk;
    float* ds = p.sl + (size_t)u * 4096; float* dp = p.pt + (size_t)u * 4096;
#pragma unroll
    for (int e = 0; e < 4; e++) {
      *(float4*)(ds + v * 64 + q * 16 + 4 * e) = make_float4(S2[2 * e].x, S2[2 * e].y, S2[2 * e + 1].x, S2[2 * e + 1].y);
      *(float4*)(dp + v * 64 + q * 16 + 4 * e) = make_float4(P2[2 * e].x, P2[2 * e].y, P2[2 * e + 1].x, P2[2 * e + 1].y);
    }
  }
}

__device__ void attn_unit(const Params& p, int i, int l, int grp, int seq, int head, int qblk, char* smem) {
  u16* sK = (u16*)smem; u16* sV = sK + 128 * 40;
  const int tid = ltid(), lane = tid & 63, w = tid >> 6, ql = lane & 31, hh = lane >> 5;
  const int Lq = grp ? 2048 : 256, Lk = grp ? 2560 : 256;
  const float scale2 = 0.17677669529663687f * 1.4426950408889634f;
  const float lam_init = 0.8f - 0.6f * __expf(-0.3f * (float)l);
  const float* lv = p.in[I_LAM] + i * 128;
  float d01 = 0.f, d23 = 0.f;
  for (int e = 0; e < 32; e++) { d01 += lv[e] * lv[32 + e]; d23 += lv[64 + e] * lv[96 + e]; }
  const float lam = expf(d01) - expf(d23) + lam_init;
  const int q0 = qblk * 128 + w * 32;
  const u16* VT = (grp ? p.vt_ii : p.vt_i) + (size_t)(seq * 8 + head) * 64 * Lk;
  const int nkt = Lk >> 7;
  f32x16 om0[2];
  f32x16 O[2];
#pragma unroll 1
  for (int m = 0; m < 2; m++) {
    const u16* Q = (grp ? p.qb_ii : p.qb_i) + (size_t)((seq * 8 + head) * 2 + m) * Lq * 32;
    const u16* Kp = (grp ? p.kb_ii : p.kb_i) + (size_t)((seq * 8 + head) * 2 + m) * Lk * 32;
    const bf16x8 qf0 = *(const bf16x8*)(Q + (size_t)(q0 + ql) * 32 + 8 * hh);
    const bf16x8 qf1 = *(const bf16x8*)(Q + (size_t)(q0 + ql) * 32 + 16 + 8 * hh);
#pragma unroll
    for (int r = 0; r < 16; r++) { O[0][r] = 0.f; O[1][r] = 0.f; }
    float mrun = -1e30f, lrun = 0.f;
    u32x4 rk[2], rv[4];
#pragma unroll
    for (int j = 0; j < 2; j++) {
      const int id = tid + 256 * j, key = id >> 2, ch = id & 3;
      rk[j] = *(const u32x4*)(Kp + (size_t)key * 32 + ch * 8);
    }
#pragma unroll
    for (int j = 0; j < 4; j++) {
      const int id = tid + 256 * j, dv = id >> 4, ch = id & 15;
      rv[j] = *(const u32x4*)(VT + (size_t)dv * Lk + ch * 8);
    }
    for (int kt = 0; kt < nkt; kt++) {
      __syncthreads();
#pragma unroll
      for (int j = 0; j < 2; j++) {
        const int id = tid + 256 * j, key = id >> 2, ch = id & 3;
        *(u32x4*)(sK + key * 40 + ch * 8) = rk[j];
      }
#pragma unroll
      for (int j = 0; j < 4; j++) {
        const int id = tid + 256 * j, dv = id >> 4, ch = id & 15;
        u32x2 lo = {rv[j][0], rv[j][1]}, hi = {rv[j][2], rv[j][3]};
        *(u32x2*)(sV + dv * 132 + ch * 8) = lo;
        *(u32x2*)(sV + dv * 132 + ch * 8 + 4) = hi;
      }
      __syncthreads();
      if (kt + 1 < nkt) {
#pragma unroll
        for (int j = 0; j < 2; j++) {
          const int id = tid + 256 * j, key = id >> 2, ch = id & 3;
          rk[j] = *(const u32x4*)(Kp + (size_t)((kt + 1) * 128 + key) * 32 + ch * 8);
        }
#pragma unroll
        for (int j = 0; j < 4; j++) {
          const int id = tid + 256 * j, dv = id >> 4, ch = id & 15;
          rv[j] = *(const u32x4*)(VT + (size_t)dv * Lk + (kt + 1) * 128 + ch * 8);
        }
      }
#pragma unroll 1
      for (int sub = 0; sub < 4; sub++) {
        bf16x8 kf0 = *(const bf16x8*)(sK + (sub * 32 + ql) * 40 + 8 * hh);
        bf16x8 kf1 = *(const bf16x8*)(sK + (sub * 32 + ql) * 40 + 16 + 8 * hh);
        f32x16 st;
#pragma unroll
        for (int r = 0; r < 16; r++) st[r] = 0.f;
        st = __builtin_amdgcn_mfma_f32_32x32x16_bf16(kf0, qf0, st, 0, 0, 0);
        st = __builtin_amdgcn_mfma_f32_32x32x16_bf16(kf1, qf1, st, 0, 0, 0);
        float mx = st[0];
#pragma unroll
        for (int r = 1; r < 16; r++) mx = fmaxf(mx, st[r]);
        mx = fmaxf(mx, __shfl_xor(mx, 32));
        const float mnew = fmaxf(mrun, mx * scale2);
        const float alpha = __builtin_amdgcn_exp2f(mrun - mnew);
        mrun = mnew;
        float psum = 0.f;
        float pe[16];
#pragma unroll
        for (int r = 0; r < 16; r++) { pe[r] = __builtin_amdgcn_exp2f(st[r] * scale2 - mnew); psum += pe[r]; }
        u32x4 pw0 = {f2bf2(pe[0], pe[1]), f2bf2(pe[2], pe[3]), f2bf2(pe[4], pe[5]), f2bf2(pe[6], pe[7])};
        u32x4 pw1 = {f2bf2(pe[8], pe[9]), f2bf2(pe[10], pe[11]), f2bf2(pe[12], pe[13]), f2bf2(pe[14], pe[15])};
        const bf16x8 pb0 = __builtin_bit_cast(bf16x8, pw0), pb1 = __builtin_bit_cast(bf16x8, pw1);
        lrun = lrun * alpha + psum;
        const bool resc = __builtin_amdgcn_ballot_w64(alpha != 1.f) != 0ull;
#pragma unroll
        for (int dvt = 0; dvt < 2; dvt++) {
          const u16* vp = sV + (dvt * 32 + ql) * 132 + sub * 32 + 4 * hh;
          bf16x4 v00 = *(const bf16x4*)(vp), v01 = *(const bf16x4*)(vp + 8), v10 = *(const bf16x4*)(vp + 16), v11 = *(const bf16x4*)(vp + 24);
          bf16x8 vf0 = {v00[0], v00[1], v00[2], v00[3], v01[0], v01[1], v01[2], v01[3]};
          bf16x8 vf1 = {v10[0], v10[1], v10[2], v10[3], v11[0], v11[1], v11[2], v11[3]};
          if (resc) {
#pragma unroll
            for (int r = 0; r < 16; r++) O[dvt][r] *= alpha;
          }
          __builtin_amdgcn_s_setprio(1);
          O[dvt] = __builtin_amdgcn_mfma_f32_32x32x16_bf16(vf0, pb0, O[dvt], 0, 0, 0);
          O[dvt] = __builtin_amdgcn_mfma_f32_32x32x16_bf16(vf1, pb1, O[dvt], 0, 0, 0);
          __builtin_amdgcn_s_setprio(0);
        }
      }
    }
    __syncthreads();
    const float lf = lrun + __shfl_xor(lrun, 32);
    const float inv = 1.f / lf;
    if (m == 0) {
#pragma unroll
      for (int r = 0; r < 16; r++) { om0[0][r] = O[0][r] * inv; om0[1][r] = O[1][r] * inv; }
    } else {
#pragma unroll
      for (int r = 0; r < 16; r++) { O[0][r] = om0[0][r] - lam * O[0][r] * inv; O[1][r] = om0[1][r] - lam * O[1][r] * inv; }
    }
  }
  float ss = 0.f;
#pragma unroll
  for (int r = 0; r < 16; r++) ss += O[0][r] * O[0][r] + O[1][r] * O[1][r];
  ss += __shfl_xor(ss, 32);
  const float rinv = rsqrtf(ss * (1.f / 64.f) + 1e-5f) * (1.f - lam_init);
  const float* sg = p.in[I_SUBG] + i * 64;
  const int tok = (grp ? 4096 + seq * 2048 : seq * 256) + q0 + ql;
#pragma unroll
  for (int dvt = 0; dvt < 2; dvt++)
#pragma unroll
    for (int g4 = 0; g4 < 4; g4++) {
      const int dv = dvt * 32 + 8 * g4 + 4 * hh;
      bf16x4 pk;
#pragma unroll
      for (int e = 0; e < 4; e++) pk[e] = (short)f2bf(O[dvt][g4 * 4 + e] * rinv * sg[dv + e]);
      *(bf16x4*)(p.H + (size_t)tok * 1024 + head * 64 + dv) = pk;
    }
}

__device__ void phase_mix(const Params& p, int i, int l, char* smem) {
  for (int item0 = lbid() - vbi(); item0 < 1024; item0 += vgrid()) {
    const int item = min(item0 + vbi(), 1023);
    if (item < 256) {
      int chunk = item & 7, dir = (item >> 3) & 1, h = (item >> 4) & 7, b = item >> 7;
      scan_unit2(p, i, b, h, dir, chunk, smem);
    } else if (item < 512) {
      int u = item - 256; int dir = u & 1, h = (u >> 1) & 7, seq = u >> 4;
      scan_unit(p, i, 0, seq, h, dir, 0, 0, smem);
    } else if (item < 768) {
      int u = item - 512; int qblk = u & 1, head = (u >> 1) & 7, seq = u >> 4;
      attn_unit(p, i, l, 0, seq, head, qblk, smem);
    } else {
      int u = item - 768; int qblk = u & 15, head = (u >> 4) & 7, b = u >> 7;
      attn_unit(p, i, l, 1, b, head, qblk, smem);
    }
  }
}

__device__ __forceinline__ void gn_store(const Params& p, int i, int tok, int c, float y) {
  float mu = wsum_fast(y) * (1.f / 64.f);
  float d = y - mu;
  float var = wsum_fast(d * d) * (1.f / 64.f);
  float yn = d * rsqrtf(var + 64e-5f);
  float o = (yn * p.in[I_LNG][i * 512 + c] + p.in[I_LNB][i * 512 + c]) * bf2f(p.g[(size_t)tok * 512 + c]);
  p.H[(size_t)tok * 1024 + 512 + c] = f2bf(o);
}

__device__ void phase_fin(const Params& p, int i, char* smem) {
  float* SS = (float*)smem; float* tP = SS + 64 * 65; float* zbuf = tP + 4096; float* ybuf = zbuf + 4096;
  const int tid = ltid(), lane = tid & 63, w = tid >> 6;
  for (int item0 = lbid() - vbi(); item0 < 1024; item0 += vgrid()) {
    const int item = min(item0 + vbi(), 1023);
    if (item < 512) {
      const int qt = item & 3, ct = (item >> 2) & 7, h = (item >> 5) & 7, b = item >> 8;
      const int v = tid >> 2, q = tid & 3;
      float accF[16], accB[16];
#pragma unroll 1
      for (int dirn = 0; dirn < 2; dirn++) {
        const float* s0 = p.in[dirn ? I_SB : I_SF] + ((size_t)((b * 2 + i) * 8 + h)) * 4096;
        float acc[16];
#pragma unroll
        for (int e = 0; e < 16; e++) acc[e] = s0[v * 64 + q * 16 + e];
        const int cEnd = dirn ? 7 - ct : ct;
        const int ub0 = ((b * 8 + h) * 2 + dirn) * 8;
        float pn[16], sn[16];
        if (cEnd > 0) {
#pragma unroll
          for (int e = 0; e < 16; e++) { pn[e] = p.pt[(size_t)ub0 * 4096 + tid + NT * e]; sn[e] = p.sl[(size_t)ub0 * 4096 + v * 64 + q * 16 + e]; }
        }
        for (int cc = 0; cc < cEnd; cc++) {
          __syncthreads();
#pragma unroll
          for (int e = 0; e < 16; e++) SS[v * 65 + q * 16 + e] = acc[e];
#pragma unroll
          for (int e = 0; e < 16; e++) tP[tid + NT * e] = pn[e];
          __syncthreads();
#pragma unroll
          for (int e = 0; e < 16; e++) acc[e] = sn[e];
          if (cc + 1 < cEnd) {
#pragma unroll
            for (int e = 0; e < 16; e++) { pn[e] = p.pt[(size_t)(ub0 + cc + 1) * 4096 + tid + NT * e]; sn[e] = p.sl[(size_t)(ub0 + cc + 1) * 4096 + v * 64 + q * 16 + e]; }
          }
#pragma unroll 4
          for (int k = 0; k < 64; k++) {
            const float sv = SS[v * 65 + k];
            const float4* pr = (const float4*)(tP + k * 64 + q * 16);
#pragma unroll
            for (int e = 0; e < 4; e++) { float4 pv = pr[e]; acc[4 * e] += sv * pv.x; acc[4 * e + 1] += sv * pv.y; acc[4 * e + 2] += sv * pv.z; acc[4 * e + 3] += sv * pv.w; }
          }
        }
        if (dirn == 0) {
#pragma unroll
          for (int e = 0; e < 16; e++) accF[e] = acc[e];
        } else {
#pragma unroll
          for (int e = 0; e < 16; e++) accB[e] = acc[e];
        }
      }
      for (int tb = qt * 64; tb < qt * 64 + 64; tb += 32) {
        const int tokii0 = b * 2048 + ct * 256 + tb;
        __syncthreads();
        for (int e = tid; e < 4096; e += NT) {
          const int dirn = e >> 11, tt = (e >> 6) & 31, k = e & 63;
          zbuf[e] = p.zb[((size_t)dirn * 4096 + tokii0 + tt) * 512 + h * 64 + k];
        }
        __syncthreads();
#pragma unroll 2
        for (int tt = 0; tt < 32; tt++) {
          const float4* zf = (const float4*)(zbuf + tt * 64 + q * 16);
          const float4* zb = (const float4*)(zbuf + 2048 + tt * 64 + q * 16);
          float part = 0.f;
#pragma unroll
          for (int e = 0; e < 4; e++) {
            float4 a = zf[e], c4 = zb[e];
            part += accF[4 * e] * a.x + accF[4 * e + 1] * a.y + accF[4 * e + 2] * a.z + accF[4 * e + 3] * a.w;
            part += accB[4 * e] * c4.x + accB[4 * e + 1] * c4.y + accB[4 * e + 2] * c4.z + accB[4 * e + 3] * c4.w;
          }
          part += __shfl_xor(part, 1); part += __shfl_xor(part, 2);
          if (q == 0) ybuf[tt * 64 + v] = part;
        }
        __syncthreads();
#pragma unroll
        for (int t8 = 0; t8 < 8; t8++) {
          const int tt = w + 4 * t8;
          const int tok = 4096 + tokii0 + tt;
          const int c = h * 64 + lane;
          float y = ybuf[tt * 64 + lane] + p.yl[(size_t)tok * 512 + c] + p.yl[((size_t)8192 + tok) * 512 + c];
          gn_store(p, i, tok, c, y);
        }
      }
      __syncthreads();
    } else {
      const int tb = (item - 512) * 8;
#pragma unroll 8
      for (int w16 = 0; w16 < 16; w16++) {
        const int wi = w + 4 * w16;
        const int tok = tb + (wi >> 3), h = wi & 7, c = h * 64 + lane;
        float y = p.yl[(size_t)tok * 512 + c] + p.yl[((size_t)8192 + tok) * 512 + c];
        gn_store(p, i, tok, c, y);
      }
    }
  }
}

__device__ __forceinline__ float2 cmul(float2 a, float2 b) { return make_float2(a.x * b.x - a.y * b.y, a.x * b.y + a.y * b.x); }

__device__ void fft_dif(float2* x, int npts, int nf) {
  for (int s = nf >> 1; s >= 1; s >>= 1) {
    const float inv2s = 0.5f / (float)s;
    for (int idx = ltid(); idx < (npts >> 1); idx += NT) {
      const int j = idx & (s - 1); const int base = ((idx - j) << 1) + j;
      float2 a = x[base], b = x[base + s];
      const float rev = -(float)j * inv2s;
      const float wr = __builtin_amdgcn_cosf(rev), wi = __builtin_amdgcn_sinf(rev);
      float2 d = make_float2(a.x - b.x, a.y - b.y);
      x[base] = make_float2(a.x + b.x, a.y + b.y);
      x[base + s] = make_float2(d.x * wr - d.y * wi, d.x * wi + d.y * wr);
    }
    __syncthreads();
  }
}
__device__ void fft_dit_inv(float2* x, int npts, int nf) {
  for (int s = 1; s <= (nf >> 1); s <<= 1) {
    const float inv2s = 0.5f / (float)s;
    for (int idx = ltid(); idx < (npts >> 1); idx += NT) {
      const int j = idx & (s - 1); const int base = ((idx - j) << 1) + j;
      float2 a = x[base], b = x[base + s];
      const float rev = -(float)j * inv2s;
      const float wr = __builtin_amdgcn_cosf(rev), wi = __builtin_amdgcn_sinf(rev);
      float2 bb = make_float2(b.x * wr + b.y * wi, b.y * wr - b.x * wi);
      x[base] = make_float2(a.x + bb.x, a.y + bb.y);
      x[base + s] = make_float2(a.x - bb.x, a.y - bb.y);
    }
    __syncthreads();
  }
}

__device__ __forceinline__ float shortc(const float* pr, int m, int L, float w0, float w1, float w2, float b0) {
  return w0 * (m > 0 ? pr[-1] : 0.f) + w1 * pr[0] + w2 * (m < L - 1 ? pr[1] : 0.f) + b0;
}

template <int NF>
__device__ void hyena_item(const Params& p, int jl, int c, char* smem) {
  constexpr int L = NF / 2;
  constexpr int grp = (NF == 4096) ? 1 : 0;
  float2* bufA = (float2*)smem; float2* bufB = bufA + 4096; float* w3c = (float*)(bufB + 4096);
  const int tid = ltid();
  const float* HD = p.hd + (size_t)(jl * 2 + grp) * 2048 * 64;
  float2* u1 = p.u1buf + (size_t)lbid() * 4096;
  w3c[tid] = p.in[I_FW3][(size_t)jl * 64 * 4096 + (size_t)(tid & 63) * 4096 + (tid >> 6) * 1024 + c];
  const float MINd = -3.0701134573253944f, MAXd = -15.350567286626973f;
  const float delta = fabsf(MINd + (MAXd - MINd) * (float)c / 1023.f);
  const float* cw = p.in[I_HYCW] + (size_t)jl * 3 * 3072; const float* cb = p.in[I_HYCB] + (size_t)jl * 3072;
  const int chin = 2048 + c;
  const float vw0 = cw[chin], vw1 = cw[3072 + chin], vw2 = cw[6144 + chin], vb0 = cb[chin];
  const float* PHv = p.pht + (size_t)chin * 8192;
  __syncthreads();
#pragma unroll 1
  for (int o = 0; o < 2; o++) {
    for (int n = tid; n < NF; n += NT) {
      float val = 0.f;
      if (n != L) {
        const int t = n < L ? n : NF - n; const int dirn = n > L ? 1 : 0;
        const float4* hp = (const float4*)(HD + (size_t)t * 64); const float4* wp = (const float4*)(w3c + (o * 2 + dirn) * 64);
        float dot = 0.f;
#pragma unroll 4
        for (int e = 0; e < 16; e++) { float4 a = hp[e], b = wp[e]; dot += a.x * b.x + a.y * b.y + a.z * b.z + a.w * b.w; }
        val = dot * __expf(-((float)t / (float)(L - 1)) * delta);
      }
      bufB[n] = make_float2(val, 0.f);
    }
#pragma unroll 2
    for (int ii = 0; ii < 16; ii++) {
      const int n = tid + NT * ii; const int pair = n / NF, m = n % NF;
      float re = 0.f, im = 0.f;
      if (m < L) {
        if (o == 0) {
          const int tokRe = grp ? 4096 + m : (2 * pair) * 256 + m; const int tokIm = grp ? 6144 + m : (2 * pair + 1) * 256 + m;
          re = shortc(PHv + tokRe, m, L, vw0, vw1, vw2, vb0);
          im = shortc(PHv + tokIm, m, L, vw0, vw1, vw2, vb0);
        } else { float2 t2 = u1[n]; re = t2.x; im = t2.y; }
      }
      bufA[n] = make_float2(re, im);
    }
    __syncthreads();
    fft_dif(bufB, NF, NF);
    fft_dif(bufA, 4096, NF);
#pragma unroll 2
    for (int ii = 0; ii < 16; ii++) { const int n = tid + NT * ii; bufA[n] = cmul(bufA[n], bufB[n % NF]); }
    __syncthreads();
    fft_dit_inv(bufA, 4096, NF);
    const float bias = p.in[I_HYBIAS][(size_t)(jl * 2 + o) * 1024 + c];
    const int chg = (o == 0 ? 0 : 1024) + c;
    const float w0 = cw[chg], w1 = cw[3072 + chg], w2 = cw[6144 + chg], b0 = cb[chg];
    const float* PHg = p.pht + (size_t)chg * 8192;
#pragma unroll 2
    for (int ii = 0; ii < 16; ii++) {
      const int n = tid + NT * ii; const int pair = n / NF, m = n % NF;
      if (m < L) {
        const int tokRe = grp ? 4096 + m : (2 * pair) * 256 + m; const int tokIm = grp ? 6144 + m : (2 * pair + 1) * 256 + m;
        float2 y = bufA[n];
        float ir, iim;
        if (o == 0) { ir = shortc(PHv + tokRe, m, L, vw0, vw1, vw2, vb0); iim = shortc(PHv + tokIm, m, L, vw0, vw1, vw2, vb0); }
        else { float2 t2 = u1[n]; ir = t2.x; iim = t2.y; }
        float yr = y.x * (1.f / NF) + bias * ir, yi = y.y * (1.f / NF) + bias * iim;
        float gr = shortc(PHg + tokRe, m, L, w0, w1, w2, b0);
        float gi = shortc(PHg + tokIm, m, L, w0, w1, w2, b0);
        float ur = gr * yr, ui = gi * yi;
        if (o == 0) { u1[n] = make_float2(ur, ui); }
        else { p.H[(size_t)tokRe * 1024 + c] = f2bf(ur); p.H[(size_t)tokIm * 1024 + c] = f2bf(ui); }
      }
    }
    __syncthreads();
  }
}

__device__ __forceinline__ float shortc_h(const u16* pr, int m, int L, float w0, float w1, float w2, float b0) {
  return w0 * (m > 0 ? bf2f(pr[-1]) : 0.f) + w1 * bf2f(pr[0]) + w2 * (m < L - 1 ? bf2f(pr[1]) : 0.f) + b0;
}

template <int L>
__device__ void hyena_item2(const Params& p, int jl, int c, char* smem) {
  constexpr int NB = L / 32;
  constexpr int GLEN = 2 * L + 32;
  constexpr int SEQS = (3 * NB - 2) * 40;
  constexpr int NSEQ = 4096 / L;
  constexpr int UBLEN = NSEQ * SEQS;
  constexpr int grp = (L == 2048) ? 1 : 0;
  constexpr int poff = grp ? 256 : 0;
  u16* Gc = (u16*)smem; u16* ub = Gc + 4 * GLEN;
  const int tid = ltid(), lane = tid & 63, w = tid >> 6, l31 = lane & 31, hh = lane >> 5;
  const int tokbase = grp ? 4096 : 0;
  const float* cw = p.in[I_HYCW] + (size_t)jl * 3 * 3072; const float* cb = p.in[I_HYCB] + (size_t)jl * 3072;
  constexpr int NG = 2 * L / NT;
  u16 gtap[NG];
  auto load_taps = [&](int o) {
    const u16* FTf = p.ft + ((size_t)((o * 2 + 0) * 1024 + c)) * 2304 + poff;
    const u16* FTb = p.ft + ((size_t)((o * 2 + 1) * 1024 + c)) * 2304 + poff;
#pragma unroll
    for (int k = 0; k < NG; k++) {
      const int y = tid + NT * k;
      u16 gv = 0;
      if (y != 0) { const int x = y - L; gv = x <= 0 ? FTf[-x] : FTb[x]; }
      gtap[k] = gv;
    }
  };
  load_taps(0);
  __syncthreads();
  for (int e = tid; e < UBLEN / 8; e += NT) ((u32x4*)ub)[e] = (u32x4){0u, 0u, 0u, 0u};
  __syncthreads();
  {
    const int chin = 2048 + c;
    const float w0 = cw[chin], w1 = cw[3072 + chin], w2 = cw[6144 + chin], b0 = cb[chin];
    const u16* PHv = (const u16*)p.pht + (size_t)chin * 8192 + tokbase;
#pragma unroll 4
    for (int k = 0; k < 16; k++) {
      const int tk = tid + NT * k; const int sq = tk / L, t = tk % L;
      const float val = shortc_h(PHv + tk, t, L, w0, w1, w2, b0);
      ub[sq * SEQS + (NB - 1 + (t >> 5)) * 40 + (t & 31)] = f2bf(val);
    }
  }
  const int n = 32 * w + l31;
  const int sq = grp ? (n >> 6) : (n >> 3);
  const int a = grp ? (n & 63) : (n & 7);
  const int dlo = grp ? (32 * (w & 1) - 63) : -(NB - 1);
  const int dhi = grp ? (32 * (w & 1) + 31) : (NB - 1);
  const int i4 = l31 >> 2, ir = l31 & 3;
  const u16* Ga = Gc + ir * GLEN + (L - 4 * i4 + 8 * hh);
  const u16* Ba = ub + sq * SEQS + (a + NB - 1) * 40 + 8 * hh;
  float u1r[16];
#pragma unroll 1
  for (int o = 0; o < 2; o++) {
#pragma unroll
    for (int k = 0; k < NG; k++) {
      const int y = tid + NT * k;
#pragma unroll
      for (int r = 0; r < 4; r++) Gc[r * GLEN + y + r] = gtap[k];
    }
    __syncthreads();
    if (o == 0) load_taps(1);
    const int chg = (o == 0 ? 0 : 1024) + c;
    const u16* PHg = (const u16*)p.pht + (size_t)chg * 8192 + tokbase + sq * L;
    float gw[4][6];
#pragma unroll
    for (int g = 0; g < 4; g++)
#pragma unroll
      for (int e = 0; e < 6; e++) { const int tt = 32 * a + 8 * g + 4 * hh - 1 + e; gw[g][e] = (tt >= 0 && tt < L) ? bf2f(PHg[tt]) : 0.f; }
    f32x16 acc0, acc1;
#pragma unroll
    for (int r = 0; r < 16; r++) { acc0[r] = 0.f; acc1[r] = 0.f; }
#pragma unroll 2
    for (int d = dlo; d <= dhi; d++) {
      const u16* ga = Ga - 32 * d;
      const u16* ba = Ba - 40 * d;
      bf16x4 a0 = *(const bf16x4*)(ga), a1 = *(const bf16x4*)(ga + 4), a2 = *(const bf16x4*)(ga + 16), a3 = *(const bf16x4*)(ga + 20);
      bf16x8 af0 = {a0[0], a0[1], a0[2], a0[3], a1[0], a1[1], a1[2], a1[3]};
      bf16x8 af1 = {a2[0], a2[1], a2[2], a2[3], a3[0], a3[1], a3[2], a3[3]};
      bf16x8 bf0 = *(const bf16x8*)(ba), bf1 = *(const bf16x8*)(ba + 16);
      acc0 = __builtin_amdgcn_mfma_f32_32x32x16_bf16(af0, bf0, acc0, 0, 0, 0);
      acc1 = __builtin_amdgcn_mfma_f32_32x32x16_bf16(af1, bf1, acc1, 0, 0, 0);
    }
    const float bias = p.in[I_HYBIAS][(size_t)(jl * 2 + o) * 1024 + c];
    const float w0 = cw[chg], w1 = cw[3072 + chg], w2 = cw[6144 + chg], b0 = cb[chg];
    __syncthreads();
#pragma unroll
    for (int r = 0; r < 16; r++) {
      const int ii = ACC_ROW(r, hh);
      const int t = 32 * a + ii;
      const int ui = sq * SEQS + (a + NB - 1) * 40 + ii;
      const float uin = (o == 0) ? bf2f(ub[ui]) : u1r[r];
      const float y = acc0[r] + acc1[r] + bias * uin;
      const float gate = w0 * gw[r >> 2][r & 3] + w1 * gw[r >> 2][(r & 3) + 1] + w2 * gw[r >> 2][(r & 3) + 2] + b0;
      const float uo = gate * y;
      if (o == 0) { u1r[r] = uo; ub[ui] = f2bf(uo); }
      else p.H[(size_t)(tokbase + sq * L + t) * 1024 + c] = f2bf(uo);
    }
    __syncthreads();
  }
}

__device__ void phase_hyena(const Params& p, int jl, char* smem) {
  for (int item0 = lbid() - vbi(); item0 < 2048; item0 += vgrid()) {
    const int item = min(item0 + vbi(), 2047);
    if (item < 1024) hyena_item2<2048>(p, jl, item, smem);
    else hyena_item2<256>(p, jl, item - 1024, smem);
  }
}

__device__ void run_phase(const Params& p, int ph, char* smem, char* gsm) {
  if (ph == 0) { phase0(p, smem); return; }
  if (ph == 1) { phase1(p, smem); return; }
  int q = ph - 2, l;
  if (q < 10) l = 0; else if (q < 17) { l = 1; q -= 10; } else if (q < 27) { l = 2; q -= 17; } else if (q < 34) { l = 3; q -= 27; } else { phase_final(p); return; }
  const float* modl = p.mod + (size_t)l * 18432;
  const int i = l >> 1;
  int fq;
  if ((l & 1) == 0) {
    switch (q) {
      case 0: phase_norm(p, p.in[I_N1G] + l * 1024, modl, 0, 1); cache_conv(p, i); return;
      case 1: { EpiAbIn e{p, i}; gemm8<2>(p.H, p.wt_abin + (size_t)i * 3328 * 1024, 8192, 3328, 1024, e, gsm); return; }
      case 2: phase_prep(p, i); return;
      case 3: { EpiLora e{p, i}; gemm8<2, EpiLora, true>(p.la, p.wt_lora + (size_t)i * 2560 * 256, 8192, 2560, 256, e, gsm); return; }
      case 4: phase_mix(p, i, l, smem); return;
      case 5: phase_fin(p, i, smem); return;
      case 6: { EpiResid e{p.X, modl + 2 * 1024, nullptr}; gemm8<2>(p.H, p.wt_about + (size_t)i * 1024 * 1024, 8192, 1024, 1024, e, gsm); return; }
      default: fq = q - 7;
    }
  } else {
    switch (q) {
      case 0: phase_norm(p, p.in[I_N1G] + l * 1024, modl, 0, 1); return;
      case 1: { EpiHyIn e{(u16*)p.pht, p.in[I_HYBIN] + i * 3072}; gemm8<2>(p.wt_hyin + (size_t)i * 3072 * 1024, p.H, 3072, 8192, 1024, e, gsm);
                EpiFilt ef{p.ft}; gemm(p.w3t + (size_t)i * 4096 * 64, p.hdb + (size_t)i * 2304 * 64, 4096, 2304, 64, ef, smem); return; }
      case 2: phase_hyena(p, i, smem); return;
      case 3: { EpiResid e{p.X, modl + 2 * 1024, p.in[I_HYBOUT] + i * 1024}; gemm8<2>(p.H, p.wt_hyout + (size_t)i * 1024 * 1024, 8192, 1024, 1024, e, gsm); return; }
      default: fq = q - 4;
    }
  }
  if (fq == 0) { phase_norm(p, p.in[I_N2G] + l * 1024, modl, 3, 4); return; }
  if (fq == 1) { EpiSwiglu e{p.act}; gemm8<4>(p.H, p.wt_13 + (size_t)l * 5632 * 1024, 8192, 5632, 1024, e, gsm); return; }
  { EpiResid e{p.X, modl + 5 * 1024, nullptr}; gemm8<2>(p.act, p.wt_2 + (size_t)l * 1024 * 2816, 8192, 1024, 2816, e, gsm); }
}

#define XB_TMO      128
#define XB_XCNT(j)  (256  + 64 * (j))
#define XB_XSUB(j)  (1280 + 64 * (j))
#define XB_XGEN(j)  (2304 + 64 * (j))
#define XB_TOP      3328
#define XB_TOPGEN   3392
#define XCD_BAR_WORDS 3456
#define XB_SPIN_CAP (1u << 18)
#define LAS __attribute__((address_space(3)))

__device__ __forceinline__ unsigned xb_ld(unsigned* p)              { return __hip_atomic_load(p, __ATOMIC_RELAXED, __HIP_MEMORY_SCOPE_AGENT); }
__device__ __forceinline__ unsigned xb_add(unsigned* p, unsigned v) { return __hip_atomic_fetch_add(p, v, __ATOMIC_RELAXED, __HIP_MEMORY_SCOPE_AGENT); }
__device__ __forceinline__ unsigned xb_xcc_id() { return (unsigned)__builtin_amdgcn_s_getreg((3 << 11) | 20) & 0xFu; }
#define XB_SPIN(cond, bar) do { unsigned _sp = 0; while (cond) { __builtin_amdgcn_s_sleep(1); \
    if ((++_sp & 255u) == 0u) { if (xb_ld(&(bar)[XB_TMO])) break; if (_sp > XB_SPIN_CAP) { atomicAdd(&(bar)[XB_TMO], 1u); break; } } } } while (0)

struct XcdBarrier {
    unsigned* bar; unsigned x;
    volatile LAS unsigned* st;
};

__device__ __forceinline__ XcdBarrier xcd_barrier_post(unsigned* bar, volatile LAS unsigned* st) {
    XcdBarrier b; b.bar = bar; b.x = xb_xcc_id(); b.st = st;
    if (threadIdx.x == 0) (void)xb_add(&bar[XB_XCNT(b.x)], 1u);
    return b;
}
__device__ __forceinline__ void xcd_barrier_complete(unsigned* bar, unsigned x, unsigned& nloc, unsigned& nx) {
    const unsigned G = gridDim.x * gridDim.y * gridDim.z;
    unsigned sum, cnt, mine, sp = 0u;
    for (;;) {
        sum = 0u; cnt = 0u; mine = 0u;
#pragma unroll
        for (unsigned j = 0; j < 16; ++j) { const unsigned c = xb_ld(&bar[XB_XCNT(j)]); sum += c; cnt += (c > 0u) ? 1u : 0u; mine = (j == x) ? c : mine; }
        if (sum == G) break;
        __builtin_amdgcn_s_sleep(1);
        if ((++sp & 255u) == 0u) { if (xb_ld(&bar[XB_TMO])) break; if (sp > XB_SPIN_CAP) { atomicAdd(&bar[XB_TMO], 1u); break; } }
    }
    nloc = mine > 0u ? mine : 1u; nx = cnt > 0u ? cnt : 1u;
}

__device__ __forceinline__ void xcd_barrier(const XcdBarrier& b) {
    asm volatile("s_waitcnt vmcnt(0)" ::: "memory");
    __syncthreads();
    if (threadIdx.x == 0) {
        unsigned* bar = b.bar;
        __builtin_amdgcn_s_waitcnt(0);
        unsigned nloc = b.st[0], nx = b.st[1];
        if (nloc == 0u) { xcd_barrier_complete(bar, b.x, nloc, nx); b.st[0] = nloc; b.st[1] = nx; }
        const unsigned old = xb_add(&bar[XB_XSUB(b.x)], 1u);
        const unsigned gen = old / nloc;
        if (old + 1u == (gen + 1u) * nloc) {
            __builtin_amdgcn_fence(__ATOMIC_RELEASE, "agent");
            asm volatile("s_waitcnt vmcnt(0)" ::: "memory");
            const unsigned og = xb_add(&bar[XB_TOP], 1u);
            const unsigned tg = og / nx;
            if (og + 1u == (tg + 1u) * nx) xb_add(&bar[XB_TOPGEN], 1u);
            else XB_SPIN(xb_ld(&bar[XB_TOPGEN]) == tg, bar);
            __builtin_amdgcn_fence(__ATOMIC_ACQUIRE, "agent");
            xb_add(&bar[XB_XGEN(b.x)], 1u);
            asm volatile("s_waitcnt vmcnt(0)" ::: "memory");
        } else {
            XB_SPIN(xb_ld(&bar[XB_XGEN(b.x)]) == gen, bar);
            __builtin_amdgcn_fence(__ATOMIC_ACQUIRE, "agent");
            asm volatile("s_waitcnt vmcnt(0)" ::: "memory");
        }
    }
    __syncthreads();
}


__global__ void __launch_bounds__(512, 2) mega(Params p, int lo, int hi) {
  extern __shared__ __attribute__((aligned(16))) char smem[];
  __shared__ uint4 xb_words;
  cg::grid_group grid = cg::this_grid();
  if (threadIdx.x == 0) xb_words = make_uint4(0u, 0u, 0u, 0u);
  __syncthreads();
  XcdBarrier xb = xcd_barrier_post(p.bar, (volatile LAS unsigned*)&xb_words);
  for (int ph = lo; ph < hi; ph++) {
    run_phase(p, ph, smem + (size_t)vbi() * LDS_BYTES, smem);
    if (ph + 1 < hi) {
      if (ph == lo) grid.sync();
      else xcd_barrier(xb);
    }
  }
}

extern "C" void kernel_launch(void* const* d_in, const int* in_sizes, int n_in, void* d_out, int out_size, void* d_ws, size_t ws_size, hipStream_t stream) {
  static int grid_blocks = 0;
  if (!grid_blocks) {
    int dev = 0, cus = 0, per_cu = 0;
    hipGetDevice(&dev);
    hipDeviceGetAttribute(&cus, hipDeviceAttributeMultiprocessorCount, dev);
    hipFuncSetAttribute((const void*)mega, hipFuncAttributeMaxDynamicSharedMemorySize, 2 * LDS_BYTES);
    hipOccupancyMaxActiveBlocksPerMultiprocessor(&per_cu, mega, 512, 2 * LDS_BYTES);
    if (per_cu > 1) per_cu = 1;
    if (per_cu < 1) per_cu = 1;
    grid_blocks = cus * per_cu;
  }
  Params p;
  memset(&p, 0, sizeof(p));
  for (int i = 0; i < 46; i++) p.in[i] = (const float*)d_in[i];
  p.out = (float*)d_out;
  char* ws = (char*)d_ws; size_t off = 0;
  auto alloc = [&](size_t bytes) { char* r = ws + off; off += (bytes + 255) & ~(size_t)255; return r; };
  p.wt_abin = (u16*)alloc((size_t)2 * 3328 * 1024 * 2);
  p.wt_about = (u16*)alloc((size_t)2 * 1024 * 1024 * 2);
  p.wt_lora = (u16*)alloc((size_t)2 * 2560 * 256 * 2);
  p.wt_hyin = (u16*)alloc((size_t)2 * 3072 * 1024 * 2);
  p.wt_hyout = (u16*)alloc((size_t)2 * 1024 * 1024 * 2);
  p.wt_13 = (u16*)alloc((size_t)4 * 5632 * 1024 * 2);
  p.wt_2 = (u16*)alloc((size_t)4 * 1024 * 2816 * 2);
  p.X = (float*)alloc((size_t)8192 * 1024 * 4);
  p.H = (u16*)alloc((size_t)8192 * 1024 * 2);
  p.modp = (float*)alloc((size_t)16 * 4 * 3 * 6144 * 4);
  p.mod = (float*)alloc((size_t)4 * 3 * 6144 * 4);
  p.hd = (float*)alloc((size_t)2 * 2 * 2048 * 64 * 4);
  p.rope = (float*)alloc((size_t)2048 * 16 * 2 * 4);
  p.bar = (unsigned*)alloc(16384);
  p.hdb = (u16*)alloc((size_t)2 * 2304 * 64 * 2);
  p.w3t = (u16*)alloc((size_t)2 * 4096 * 64 * 2);
  const size_t arena = off;
  p.qb_i = (u16*)alloc((size_t)4096 * 512 * 2);
  p.qb_ii = (u16*)alloc((size_t)4096 * 512 * 2);
  p.kb_i = (u16*)alloc((size_t)4096 * 512 * 2);
  p.kb_ii = (u16*)alloc((size_t)2 * 8 * 2 * 2560 * 32 * 2);
  p.vt_i = (u16*)alloc((size_t)4096 * 512 * 2);
  p.vt_ii = (u16*)alloc((size_t)2 * 8 * 64 * 2560 * 2);
  p.rw = (float*)alloc((size_t)8192 * 1792 * 4);
  p.la = (u16*)alloc((size_t)8192 * 256 * 2);
  p.dec = (float*)alloc((size_t)8192 * 1024 * 4);
  p.aa = (float*)alloc((size_t)8192 * 1024 * 4);
  p.g = (u16*)alloc((size_t)8192 * 512 * 2);
  p.yl = (float*)alloc((size_t)2 * 8192 * 512 * 4);
  p.zb = (float*)alloc((size_t)2 * 4096 * 512 * 4);
  p.sl = (float*)alloc((size_t)256 * 4096 * 4);
  p.pt = (float*)alloc((size_t)256 * 4096 * 4);
  const size_t total = off;
  p.pht = (float*)(ws + arena);
  p.u1buf = (float2*)(ws + arena + (size_t)3072 * 8192 * 4);
  p.ft = (u16*)(ws + arena + (size_t)3072 * 8192 * 4);
  p.act = (u16*)(ws + arena);
  if (total > ws_size) { fprintf(stderr, "workspace too small: need %zu have %zu\n", total, ws_size); return; }
#if MULTI
  for (int ph = 0; ph < NPHASE; ph++) {
    hipLaunchKernelGGL(mega, dim3(grid_blocks), dim3(512), 2 * LDS_BYTES, stream, p, ph, ph + 1);
  }
#else
  hipMemsetAsync(p.bar, 0, 16384, stream);
  int lo = 0, hi = NPHASE;
  void* args[] = {&p, &lo, &hi};
  hipError_t e = hipLaunchCooperativeKernel((void*)mega, dim3(grid_blocks), dim3(512), args, 2 * LDS_BYTES, stream);
  if (e != hipSuccess) fprintf(stderr, "cooperative launch failed: %s (grid %d)\n", hipGetErrorString(e), grid_blocks);
#endif
}
```

```cpp
#include <hip/hip_runtime.h>
#include <hip/hip_cooperative_groups.h>
#include <cstdio>
#include <cstdint>
#include <cstring>
namespace cg = cooperative_groups;

#ifndef MULTI
#define MULTI 0
#endif

typedef unsigned short u16;
typedef __attribute__((ext_vector_type(8))) short bf16x8;
typedef __attribute__((ext_vector_type(4))) short bf16x4;
typedef __attribute__((ext_vector_type(16))) float f32x16;
typedef __attribute__((ext_vector_type(4))) unsigned u32x4;
typedef __attribute__((ext_vector_type(2))) unsigned u32x2;

#define NT 256
#define LDS_BYTES 67584
#define NPHASE 37

struct Params {
  const float* in[46];
  float* out;
  u16 *wt_abin, *wt_about, *wt_lora, *wt_hyin, *wt_hyout, *wt_13, *wt_2;
  float* X; u16* H;
  float *modp, *mod, *hd, *rope;
  u16 *qb_i, *qb_ii, *kb_i, *kb_ii, *vt_i, *vt_ii;
  float* rw; u16* la; float *dec, *aa; u16* g; float *yl, *zb, *sl, *pt;
  float* pht; u16* act; float2* u1buf; unsigned* bar; u16 *hdb, *w3t, *ft;
};

enum { I_XP=0, I_XS, I_CK, I_CV, I_SF, I_SB, I_C, I_CCTX, I_ADAW, I_ADAB, I_N1G, I_N2G, I_W1, I_W3, I_W2, I_FG,
       I_ABIN, I_ABOUT, I_LAM, I_SUBG, I_MU, I_W0, I_WUP, I_A0, I_AUP, I_GUP, I_KK, I_KA, I_RK, I_LNG, I_LNB,
       I_HYIN, I_HYBIN, I_HYCW, I_HYCB, I_FW0, I_FB0, I_FW1, I_FB1, I_FW2, I_FB2, I_FW3, I_FFREQ, I_HYBIAS, I_HYOUT, I_HYBOUT };

__device__ __forceinline__ int rtid() { int t = threadIdx.x; asm volatile("" : "+v"(t)); return t; }
__device__ __forceinline__ int rbid() { int b = blockIdx.x; asm volatile("" : "+s"(b)); return b; }
__device__ __forceinline__ int vbi() { int t = threadIdx.x; asm volatile("" : "+v"(t)); return __builtin_amdgcn_readfirstlane(t >> 8); }
__device__ __forceinline__ int ltid() { int t = threadIdx.x; asm volatile("" : "+v"(t)); return t & 255; }
__device__ __forceinline__ int lbid() { int b = blockIdx.x; asm volatile("" : "+s"(b)); return b * 2 + vbi(); }
__device__ __forceinline__ int vgrid() { int g = (int)gridDim.x; asm volatile("" : "+s"(g)); return g * 2; }
typedef __bf16 hbf16x2 __attribute__((ext_vector_type(2)));
typedef float f32x2_t __attribute__((ext_vector_type(2)));
__device__ __forceinline__ u16 f2bf(float f) { return __builtin_bit_cast(unsigned short, (__bf16)f); }
__device__ __forceinline__ unsigned f2bf2(float a, float b) { f32x2_t v = {a, b}; return __builtin_bit_cast(unsigned, __builtin_convertvector(v, hbf16x2)); }
__device__ __forceinline__ float bf2f(u16 h) { return __uint_as_float(((unsigned)h) << 16); }
__device__ __forceinline__ float wsum(float v) { for (int o = 32; o > 0; o >>= 1) v += __shfl_xor(v, o); return v; }
__device__ __forceinline__ float sigm(float x) { return 1.f / (1.f + __expf(-x)); }
__device__ __forceinline__ int cnd_of(int row) { return row < 4096 ? 0 : 1 + ((row - 4096) >> 11); }
typedef float f32x2 __attribute__((ext_vector_type(2)));
__device__ __forceinline__ float dppf(float v, int ctrl) { return v; }
#define DPP_ADD(v, ctrl) ((v) + __int_as_float(__builtin_amdgcn_update_dpp(0, __float_as_int(v), (ctrl), 0xF, 0xF, true)))
__device__ __forceinline__ float wsum_fast(float v) {
  v = DPP_ADD(v, 0xB1); v = DPP_ADD(v, 0x4E); v = DPP_ADD(v, 0x141); v = DPP_ADD(v, 0x140);
  v += __shfl_xor(v, 16); v += __shfl_xor(v, 32);
  return v;
}


#define ACC_ROW(r, hh) (((r) & 3) + 8 * ((r) >> 2) + 4 * (hh))
template <bool LORA = false, class Epi>
__device__ void gemm(const u16* __restrict__ A, const u16* __restrict__ Bt, int M, int N, int K, const Epi& epi, char* smem) {
  u16* sA = (u16*)smem; u16* sB = sA + 128 * 72;
  const int tid = ltid(), lane = tid & 63, w = tid >> 6, wm = w >> 1, wn = w & 1, l31 = lane & 31, hh = lane >> 5;
  const int ntm = M / 128, ntn = N / 128, nk = K / 64;
  for (int tile0 = lbid() - vbi(); tile0 < ntm * ntn; tile0 += vgrid()) {
    const bool active = tile0 + vbi() < ntm * ntn;
    const int tile = min(tile0 + vbi(), ntm * ntn - 1);
    const int tm = tile % ntm, tn = tile / ntm;
    int k0 = 0, nkl = nk;
    if (LORA) { if (tn < 8) { k0 = 0; nkl = 1; } else if (tn < 16) { k0 = 1; nkl = 1; } else { k0 = 2; nkl = 2; } }
    const u16* Ag = A + (size_t)(tm * 128) * K + k0 * 64; const u16* Bg = Bt + (size_t)(tn * 128) * K + k0 * 64;
    f32x16 acc[2][2];
#pragma unroll
    for (int i = 0; i < 2; i++)
#pragma unroll
      for (int j = 0; j < 2; j++)
#pragma unroll
        for (int r = 0; r < 16; r++) acc[i][j][r] = 0.f;
    u32x4 ra[4], rb[4], rc[4], rd[4];
    unsigned offs[4];
#pragma unroll
    for (int i = 0; i < 4; i++) { int id = tid + 256 * i, row = id >> 3, kc = id & 7; offs[i] = (unsigned)(row * K + kc * 8); }
#define GLOAD(RA, RB, KT) \
    { const u16* Ak = Ag + (size_t)(KT) * 64; const u16* Bk = Bg + (size_t)(KT) * 64; \
    _Pragma("unroll") for (int i = 0; i < 4; i++) { RA[i] = *(const u32x4*)(Ak + offs[i]); RB[i] = *(const u32x4*)(Bk + offs[i]); } }
#define KSTEP(RA, RB, KTN) \
    _Pragma("unroll") for (int i = 0; i < 4; i++) { int id = tid + 256 * i, row = id >> 3, kc = id & 7; \
      *(u32x4*)(sA + row * 72 + kc * 8) = RA[i]; *(u32x4*)(sB + row * 72 + kc * 8) = RB[i]; } \
    __syncthreads(); \
    if ((KTN) < nkl) { GLOAD(RA, RB, KTN) } \
    _Pragma("unroll 2") for (int kc = 0; kc < 4; kc++) { \
      bf16x8 a0 = *(const bf16x8*)(sA + (wm * 64 + l31) * 72 + kc * 16 + hh * 8); \
      bf16x8 a1 = *(const bf16x8*)(sA + (wm * 64 + 32 + l31) * 72 + kc * 16 + hh * 8); \
      bf16x8 b0 = *(const bf16x8*)(sB + (wn * 64 + l31) * 72 + kc * 16 + hh * 8); \
      bf16x8 b1 = *(const bf16x8*)(sB + (wn * 64 + 32 + l31) * 72 + kc * 16 + hh * 8); \
      acc[0][0] = __builtin_amdgcn_mfma_f32_32x32x16_bf16(a0, b0, acc[0][0], 0, 0, 0); \
      acc[0][1] = __builtin_amdgcn_mfma_f32_32x32x16_bf16(a0, b1, acc[0][1], 0, 0, 0); \
      acc[1][0] = __builtin_amdgcn_mfma_f32_32x32x16_bf16(a1, b0, acc[1][0], 0, 0, 0); \
      acc[1][1] = __builtin_amdgcn_mfma_f32_32x32x16_bf16(a1, b1, acc[1][1], 0, 0, 0); } \
    __syncthreads();
    GLOAD(ra, rb, 0)
    if (nkl > 1) { GLOAD(rc, rd, 1) }
    for (int kt = 0; kt < nkl; kt += 2) {
      KSTEP(ra, rb, kt + 2)
      if (kt + 1 < nkl) { KSTEP(rc, rd, kt + 3) }
    }
#undef GLOAD
#undef KSTEP
    {
      float* T = (float*)smem + w * (64 * 65);
#pragma unroll
      for (int ti = 0; ti < 2; ti++)
#pragma unroll
        for (int tj = 0; tj < 2; tj++)
#pragma unroll
          for (int r = 0; r < 16; r++) T[(ti * 32 + ACC_ROW(r, hh)) * 65 + tj * 32 + l31] = acc[ti][tj][r];
      __syncthreads();
      if (active) epi.run(T, tm * 128 + wm * 64, tn * 128 + wn * 64, lane);
      __syncthreads();
    }
  }
}

template <class E> struct EpiDirect { static constexpr bool value = false; };
template <int NJ, class Epi, bool LORA = false>
__device__ void gemm8(const u16* __restrict__ A, const u16* __restrict__ Bt, int M, int N, int K, const Epi& epi, char* smem) {
  constexpr int BN = NJ * 64, WN = NJ * 32;
  constexpr int STAGE = 256 * 64 + BN * 64;
  u16* s0 = (u16*)smem;
  const int tid = rtid(), lane = tid & 63, w = tid >> 6, wm = w >> 1, wn = w & 1, l31 = lane & 31, hh = lane >> 5;
  const int ntm = M / 256, ntn = N / BN, nk = K / 64;
  const int rgrid = vgrid() >> 1;
  const int sw = (l31 >> 1) & 7;
  const int fa0 = (wm * 64 + l31) * 64, fa1 = fa0 + 32 * 64, fb0 = 256 * 64 + (wn * WN + l31) * 64;
  for (int tile = rbid(); tile < ntm * ntn; tile += rgrid) {
    const int tm = tile % ntm, tn = tile / ntm;
    int k0 = 0, nkl = nk;
    if (LORA) { if (tn < 8) { k0 = 0; nkl = 1; } else if (tn < 16) { k0 = 1; nkl = 1; } else { k0 = 2; nkl = 2; } }
    const u16* Ag = A + (size_t)(tm * 256) * K + k0 * 64; const u16* Bg = Bt + (size_t)(tn * BN) * K + k0 * 64;
    f32x16 acc[2][NJ];
#pragma unroll
    for (int i = 0; i < 2; i++)
#pragma unroll
      for (int j = 0; j < NJ; j++)
#pragma unroll
        for (int r = 0; r < 16; r++) acc[i][j][r] = 0.f;
    unsigned offs[4]; int wofs[4];
#pragma unroll
    for (int i = 0; i < 4; i++) { int id = tid + 512 * i, row = id >> 3, kc = id & 7; offs[i] = (unsigned)(row * K + kc * 8); wofs[i] = row * 64 + ((kc ^ ((row >> 1) & 7)) << 3); }
    u32x4 ra[4], rb[NJ];
#define GLOAD8(KT) \
    { const u16* Ak = Ag + (size_t)(KT) * 64; const u16* Bk = Bg + (size_t)(KT) * 64; \
    _Pragma("unroll") for (int i = 0; i < 4; i++) ra[i] = *(const u32x4*)(Ak + offs[i]); \
    _Pragma("unroll") for (int i = 0; i < NJ; i++) rb[i] = *(const u32x4*)(Bk + offs[i]); }
#define LSTORE8(ST) \
    { _Pragma("unroll") for (int i = 0; i < 4; i++) *(u32x4*)((ST) + wofs[i]) = ra[i]; \
      _Pragma("unroll") for (int i = 0; i < NJ; i++) *(u32x4*)((ST) + 256 * 64 + wofs[i]) = rb[i]; }
    GLOAD8(0)
    __syncthreads();
    LSTORE8(s0)
    if (nkl > 1) { GLOAD8(1) }
    __syncthreads();
    for (int kt = 0; kt < nkl; kt++) {
      const u16* cur = s0 + (kt & 1) * STAGE;
      if (kt + 1 < nkl) {
        u16* nxt = s0 + ((kt + 1) & 1) * STAGE;
        LSTORE8(nxt)
        if (kt + 2 < nkl) { GLOAD8(kt + 2) }
      }
#pragma unroll 1
      for (int kc = 0; kc < 4; kc++) {
        const int co = (((kc * 2 + hh) ^ sw) << 3);
        bf16x8 a0 = *(const bf16x8*)(cur + fa0 + co);
        bf16x8 a1 = *(const bf16x8*)(cur + fa1 + co);
        bf16x8 bq[NJ];
#pragma unroll
        for (int j = 0; j < NJ; j++) bq[j] = *(const bf16x8*)(cur + fb0 + j * 32 * 64 + co);
        __builtin_amdgcn_s_setprio(1);
#pragma unroll
        for (int j = 0; j < NJ; j++) {
          acc[0][j] = __builtin_amdgcn_mfma_f32_32x32x16_bf16(a0, bq[j], acc[0][j], 0, 0, 0);
          acc[1][j] = __builtin_amdgcn_mfma_f32_32x32x16_bf16(a1, bq[j], acc[1][j], 0, 0, 0);
        }
        __builtin_amdgcn_s_setprio(0);
      }
      __syncthreads();
    }
#undef GLOAD8
#undef LSTORE8
    if constexpr (EpiDirect<Epi>::value) {
#pragma unroll
      for (int jp = 0; jp < NJ / 2; jp++)
#pragma unroll
        for (int ti = 0; ti < 2; ti++) epi.direct(acc[ti][jp * 2], acc[ti][jp * 2 + 1], tm * 256 + wm * 64 + ti * 32, tn * BN + wn * WN + jp * 64, lane);
    } else {
      float* T = (float*)smem + w * (64 * 65);
#pragma unroll
      for (int jp = 0; jp < NJ / 2; jp++) {
#pragma unroll
        for (int ti = 0; ti < 2; ti++)
#pragma unroll
          for (int tj = 0; tj < 2; tj++)
#pragma unroll
            for (int r = 0; r < 16; r++) T[(ti * 32 + ACC_ROW(r, hh)) * 65 + tj * 32 + l31] = acc[ti][jp * 2 + tj][r];
        __syncthreads();
        epi.run(T, tm * 256 + wm * 64, tn * BN + wn * WN + jp * 64, lane);
        __syncthreads();
      }
    }
  }
}

struct EpiAbIn {
  const Params& p; int i;
  __device__ void run(const float* T, int row0, int col0, int lane) const {
    const int grp = row0 >= 4096;
    const int seq = grp ? ((row0 - 4096) >> 11) : (row0 >> 8);
    const int tb = grp ? ((row0 - 4096) & 2047) : (row0 & 255);
    if (col0 < 1024) {
      const int isk = col0 >= 512;
      const int head = (col0 & 511) >> 6;
      const int m = lane >> 5, d = lane & 31;
      const int Lx = grp ? (isk ? 2560 : 2048) : 256;
      u16* base = isk ? (grp ? p.kb_ii : p.kb_i) : (grp ? p.qb_ii : p.qb_i);
      base += ((size_t)((seq * 8 + head) * 2 + m) * Lx + (grp && isk ? 512 : 0) + tb) * 32 + d;
      float* ob = p.out + 8388608 + ((size_t)((((seq * 2 + i) * 8 + head) * 2 + m) * 256 + tb)) * 32 + d;
      const float* rp = p.rope + ((size_t)tb * 16 + ((d >> 4) * 8 + (d & 7))) * 2;
      const float sgn = (d & 8) ? 1.f : -1.f;
#pragma unroll 8
      for (int rr = 0; rr < 64; rr++) {
        float val = T[rr * 65 + lane];
        if (grp) {
          float partner = T[rr * 65 + (lane ^ 8)];
          float c = rp[rr * 32], s = rp[rr * 32 + 1];
          val = val * c + sgn * partner * s;
        }
        base[rr * 32] = f2bf(val);
        if (isk && !grp) ob[rr * 32] = val;
      }
    } else if (col0 < 1536) {
      const int head = (col0 - 1024) >> 6;
      if (!grp) {
        float* ob = p.out + 12582912 + ((size_t)(((seq * 2 + i) * 8 + head) * 256 + tb)) * 64 + lane;
#pragma unroll 4
        for (int rr = 0; rr < 64; rr++) ob[rr * 64] = T[rr * 65 + lane];
      }
      const int Lk = grp ? 2560 : 256;
      u16* vb = (grp ? p.vt_ii : p.vt_i) + ((size_t)((seq * 8 + head) * 64)) * Lk + (grp ? 512 : 0) + tb + lane;
#pragma unroll 4
      for (int dv = 0; dv < 64; dv++) vb[(size_t)dv * Lk] = f2bf(T[lane * 65 + dv]);
    } else {
      float* rb = p.rw + (size_t)row0 * 1792 + (col0 - 1536) + lane;
#pragma unroll 4
      for (int rr = 0; rr < 64; rr++) rb[(size_t)rr * 1792] = T[rr * 65 + lane];
    }
  }
};

struct EpiLora {
  const Params& p; int i;
  __device__ void run(const float* T, int row0, int col0, int lane) const {
    const int col = col0 + lane;
    if (col0 < 1024) {
      const float w0 = p.in[I_W0][i * 1024 + col];
      float* db = p.dec + (size_t)row0 * 1024 + col;
#pragma unroll 2
      for (int rr = 0; rr < 64; rr++) {
        float x = w0 + T[rr * 65 + lane];
        float z = -x;
        float sp = z > 20.f ? z : __logf(1.f + __expf(z));
        float wv = -sp - 0.5f;
        db[(size_t)rr * 1024] = __expf(-__expf(wv));
      }
    } else if (col0 < 2048) {
      const float a0 = p.in[I_A0][i * 1024 + (col - 1024)];
      float* ab = p.aa + (size_t)row0 * 1024 + (col - 1024);
#pragma unroll 4
      for (int rr = 0; rr < 64; rr++) ab[(size_t)rr * 1024] = sigm(a0 + T[rr * 65 + lane]);
    } else {
      u16* gb = p.g + (size_t)row0 * 512 + (col - 2048);
#pragma unroll 4
      for (int rr = 0; rr < 64; rr++) gb[(size_t)rr * 512] = f2bf(T[rr * 65 + lane]);
    }
  }
};

struct EpiResid {
  float* X; const float* gate; const float* bias;
  __device__ void run(const float* T, int row0, int col0, int lane) const {
    const int cnd = cnd_of(row0);
    const int col = col0 + lane;
    const float gt = gate[cnd * 6144 + col];
    const float bs = bias ? bias[col] : 0.f;
    float* xb = X + (size_t)row0 * 1024 + col;
#pragma unroll 1
    for (int r0 = 0; r0 < 64; r0 += 16) {
      float xv[16];
#pragma unroll
      for (int k = 0; k < 16; k++) xv[k] = xb[(size_t)(r0 + k) * 1024];
#pragma unroll
      for (int k = 0; k < 16; k++) xb[(size_t)(r0 + k) * 1024] = xv[k] + gt * (T[(r0 + k) * 65 + lane] + bs);
    }
  }
};

struct EpiSwiglu {
  u16* act;
  __device__ __forceinline__ void direct(const f32x16& a, const f32x16& b, int row0, int col0, int lane) const {
    const int l31 = lane & 31, hh = lane >> 5;
    u16* ab = act + (size_t)row0 * 2816 + (col0 >> 1) + l31;
#pragma unroll
    for (int r = 0; r < 16; r++) {
      const float av = a[r], bv = b[r];
      ab[(size_t)ACC_ROW(r, hh) * 2816] = f2bf(av * sigm(av) * bv);
    }
  }
  __device__ void run(const float* T, int row0, int col0, int lane) const {
    const int c = lane & 31, ro = lane >> 5;
    u16* ab = act + (size_t)(row0 + ro) * 2816 + (col0 >> 1) + c;
#pragma unroll 4
    for (int it = 0; it < 32; it++) {
      const int rr = 2 * it + ro;
      float a = T[rr * 65 + c], b = T[rr * 65 + 32 + c];
      ab[(size_t)(2 * it) * 2816] = f2bf(a * sigm(a) * b);
    }
  }
};

template <> struct EpiDirect<EpiSwiglu> { static constexpr bool value = true; };

struct EpiHyIn {
  u16* pht; const float* bin;
  __device__ void run(const float* T, int row0, int col0, int lane) const {
    u16* pb = pht + (size_t)row0 * 8192 + col0 + lane;
#pragma unroll 4
    for (int rr = 0; rr < 64; rr++) pb[(size_t)rr * 8192] = f2bf(T[rr * 65 + lane] + bin[row0 + rr]);
  }
};

struct EpiFilt {
  u16* ft;
  __device__ void run(const float* T, int row0, int col0, int lane) const {
    const int pidx = col0 + lane;
    const float tn = pidx < 256 ? (float)pidx * (1.f / 255.f) : (float)(pidx - 256) * (1.f / 2047.f);
    const float MINd = -3.0701134573253944f, MAXd = -15.350567286626973f;
    u16* fb = ft + (size_t)row0 * 2304 + pidx;
#pragma unroll 4
    for (int rr = 0; rr < 64; rr++) {
      const int c = (row0 + rr) & 1023;
      const float delta = fabsf(MINd + (MAXd - MINd) * (float)c / 1023.f);
      fb[(size_t)rr * 2304] = f2bf(T[rr * 65 + lane] * __expf(-tn * delta));
    }
  }
};

__device__ void convT(const float* __restrict__ src, int K, int N, u16* __restrict__ dst, int ldd, int koff, int grp, int stride, int off, float* sm) {
  const int tid = ltid();
  const int nkt = K / 64, nnt = N / 64, ntot = nkt * nnt;
  const int c = tid & 63, r0 = tid >> 6;
  float v[16];
  int tile0 = lbid() - vbi();
  if (tile0 < ntot) {
    const int tile = min(tile0 + vbi(), ntot - 1); const int kt = tile % nkt, nt = tile / nkt;
#pragma unroll
    for (int i = 0; i < 16; i++) v[i] = __builtin_nontemporal_load(&src[(size_t)(kt * 64 + r0 + 4 * i) * N + nt * 64 + c]);
  }
  for (; tile0 < ntot; tile0 += vgrid()) {
    const int tile = min(tile0 + vbi(), ntot - 1);
    const int kt = tile % nkt, nt = tile / nkt;
#pragma unroll
    for (int i = 0; i < 16; i++) sm[(r0 + 4 * i) * 65 + c] = v[i];
    __syncthreads();
    if (tile0 + vgrid() < ntot) {
      const int tl2 = min(tile0 + vgrid() + vbi(), ntot - 1); const int kt2 = tl2 % nkt, nt2 = tl2 / nkt;
#pragma unroll
      for (int i = 0; i < 16; i++) v[i] = __builtin_nontemporal_load(&src[(size_t)(kt2 * 64 + r0 + 4 * i) * N + nt2 * 64 + c]);
    }
#pragma unroll
    for (int i = 0; i < 2; i++) {
      const int nl = (tid >> 3) + 32 * i, kc = tid & 7;
      bf16x8 pk;
#pragma unroll
      for (int j = 0; j < 8; j++) pk[j] = (short)f2bf(sm[(kc * 8 + j) * 65 + nl]);
      const int n = nt * 64 + nl;
      const int drow = (n / grp) * stride + off + (n % grp);
      *(bf16x8*)(dst + (size_t)drow * ldd + koff + kt * 64 + kc * 8) = pk;
    }
    __syncthreads();
  }
}

__device__ void phase0(const Params& p, char* smem) {
  float* sm = (float*)smem;
  const int tid = ltid(), lane = tid & 63, w = tid >> 6;
  const int gtid = lbid() * NT + tid, gsz = vgrid() * NT;
  for (int item0 = lbid() - vbi(); item0 < 384; item0 += vgrid()) {
    const int item = min(item0 + vbi(), 383);
    const int l = item / 96, kc = (item / 6) % 16, nb = item % 6;
    if (tid < 192) {
      int cnd = tid >> 6, kk = tid & 63, k = kc * 64 + kk;
      float x = cnd == 0 ? p.in[I_CCTX][k] : p.in[I_C][(cnd - 1) * 1024 + k];
      sm[tid] = x * sigm(x);
    }
    __syncthreads();
    const int n4 = nb * 256 + tid;
    const float4* W = (const float4*)(p.in[I_ADAW] + (size_t)(l * 1024 + kc * 64) * 6144) + n4;
    float4 a0 = {0, 0, 0, 0}, a1 = a0, a2 = a0;
#pragma unroll 16
    for (int kk = 0; kk < 64; kk++) {
      typedef float f32x4v __attribute__((ext_vector_type(4)));
      const f32x4v wq = __builtin_nontemporal_load((const f32x4v*)&W[(size_t)kk * 1536]);
      float4 wv = {wq[0], wq[1], wq[2], wq[3]};
      float s0 = sm[kk], s1 = sm[64 + kk], s2 = sm[128 + kk];
      a0.x += s0 * wv.x; a0.y += s0 * wv.y; a0.z += s0 * wv.z; a0.w += s0 * wv.w;
      a1.x += s1 * wv.x; a1.y += s1 * wv.y; a1.z += s1 * wv.z; a1.w += s1 * wv.w;
      a2.x += s2 * wv.x; a2.y += s2 * wv.y; a2.z += s2 * wv.z; a2.w += s2 * wv.w;
    }
    float* mp = p.modp + ((size_t)(kc * 4 + l) * 3) * 6144 + n4 * 4;
    *(float4*)(mp) = a0; *(float4*)(mp + 6144) = a1; *(float4*)(mp + 12288) = a2;
    __syncthreads();
  }
  for (int i = 0; i < 2; i++) {
    convT(p.in[I_ABIN] + (size_t)i * 1024 * 3328, 1024, 3328, p.wt_abin + (size_t)i * 3328 * 1024, 1024, 0, 3328, 0, 0, sm);
    convT(p.in[I_ABOUT] + (size_t)i * 1024 * 1024, 1024, 1024, p.wt_about + (size_t)i * 1024 * 1024, 1024, 0, 1024, 0, 0, sm);
    convT(p.in[I_HYIN] + (size_t)i * 1024 * 3072, 1024, 3072, p.wt_hyin + (size_t)i * 3072 * 1024, 1024, 0, 3072, 0, 0, sm);
    convT(p.in[I_HYOUT] + (size_t)i * 1024 * 1024, 1024, 1024, p.wt_hyout + (size_t)i * 1024 * 1024, 1024, 0, 1024, 0, 0, sm);
  }
  for (int jl = 0; jl < 2; jl++) convT(p.in[I_FW3] + (size_t)jl * 64 * 4096, 64, 4096, p.w3t + (size_t)jl * 4096 * 64, 64, 0, 4096, 0, 0, sm);
  for (int l = 0; l < 4; l++) {
    convT(p.in[I_W1] + (size_t)l * 1024 * 2816, 1024, 2816, p.wt_13 + (size_t)l * 5632 * 1024, 1024, 0, 32, 64, 0, sm);
    convT(p.in[I_W3] + (size_t)l * 1024 * 2816, 1024, 2816, p.wt_13 + (size_t)l * 5632 * 1024, 1024, 0, 32, 64, 32, sm);
    convT(p.in[I_W2] + (size_t)l * 2816 * 1024, 2816, 1024, p.wt_2 + (size_t)l * 1024 * 2816, 2816, 0, 1024, 0, 0, sm);
  }
  for (int i = gtid; i < 163840; i += gsz) ((uint4*)p.wt_lora)[i] = make_uint4(0, 0, 0, 0);
  for (int item0 = lbid() - vbi(); item0 < 1152; item0 += vgrid()) {
    const int item = min(item0 + vbi(), 1151);
    const int jl = item / 576, pos = (item % 576) * 4 + w;
    int L, t, sel;
    if (pos < 256) { L = 256; t = pos; sel = 0; } else { L = 2048; t = pos - 256; sel = 1; }
    float* zs = sm + w * 128; float* hs = zs + 64;
    if (lane < 33) {
      float z;
      if (lane == 0) z = (float)t / (float)(L - 1);
      else {
        int b = (lane - 1) & 15;
        float f = 1e-4f + (float)b * ((15.f - 1e-4f) / 15.f);
        float wpos = 6.283185307179586f * (float)t / (float)L;
        float ang = f * wpos;
        z = (lane <= 16) ? cosf(ang) : -sinf(ang);
      }
      zs[lane] = z;
    }
    __syncthreads();
    float acc = p.in[I_FB0][jl * 64 + lane];
    for (int e = 0; e < 33; e++) acc += zs[e] * p.in[I_FW0][(jl * 33 + e) * 64 + lane];
    float h = sinf(p.in[I_FFREQ][(jl * 3 + 0) * 64 + lane] * acc);
    hs[lane] = h;
    __syncthreads();
    acc = p.in[I_FB1][jl * 64 + lane];
    for (int e = 0; e < 64; e++) acc += hs[e] * p.in[I_FW1][(jl * 64 + e) * 64 + lane];
    h = sinf(p.in[I_FFREQ][(jl * 3 + 1) * 64 + lane] * acc);
    __syncthreads();
    hs[lane] = h;
    __syncthreads();
    acc = p.in[I_FB2][jl * 64 + lane];
    for (int e = 0; e < 64; e++) acc += hs[e] * p.in[I_FW2][(jl * 64 + e) * 64 + lane];
    h = sinf(p.in[I_FFREQ][(jl * 3 + 2) * 64 + lane] * acc);
    p.hd[((size_t)(jl * 2 + sel) * 2048 + t) * 64 + lane] = h;
    p.hdb[((size_t)jl * 2304 + pos) * 64 + lane] = f2bf(h);
    __syncthreads();
  }
  for (int i = gtid; i < 2097152; i += gsz) {
    float4 v = i < 1048576 ? ((const float4*)p.in[I_XP])[i] : ((const float4*)p.in[I_XS])[i - 1048576];
    ((float4*)p.X)[i] = v;
  }
  for (int i = gtid; i < 2048 * 16; i += gsz) {
    int t = i >> 4, e = i & 15, axis = e >> 3, pp = e & 7;
    float inv = powf(10000.f, -(float)pp / 8.f);
    float pos = axis ? (float)(t & 63) : (float)(t >> 6);
    float ang = pos * inv;
    p.rope[i * 2] = cosf(ang); p.rope[i * 2 + 1] = sinf(ang);
  }
}

__device__ void phase1(const Params& p, char* smem) {
  float* sm = (float*)smem;
  const int gtid = lbid() * NT + ltid(), gsz = vgrid() * NT;
  for (int idx = gtid; idx < 73728; idx += gsz) {
    int l = idx / 18432, n = idx % 6144;
    float a = p.in[I_ADAB][l * 6144 + n];
    for (int kc = 0; kc < 16; kc++) {
      int cndn = idx % 18432;
      a += p.modp[((size_t)(kc * 4 + l) * 3) * 6144 + cndn];
    }
    p.mod[idx] = a;
  }
  for (int i = 0; i < 2; i++) {
    u16* wl = p.wt_lora + (size_t)i * 2560 * 256;
    for (int d = 0; d < 2; d++) {
      convT(p.in[I_WUP] + (size_t)(i * 2 + d) * 64 * 512, 64, 512, wl + (size_t)(d * 512) * 256, 256, 0, 512, 0, 0, sm);
      convT(p.in[I_AUP] + (size_t)(i * 2 + d) * 64 * 512, 64, 512, wl + (size_t)(1024 + d * 512) * 256, 256, 64, 512, 0, 0, sm);
    }
    convT(p.in[I_GUP] + (size_t)i * 128 * 512, 128, 512, wl + (size_t)2048 * 256, 256, 128, 512, 0, 0, sm);
  }
}

__device__ __forceinline__ void norm_out(const Params& p, int row, const float4 (&v)[4], float ss, int lane, const float* g, const float* modl, int shc, int scc) {
  const float rs = rsqrtf(ss * (1.f / 1024.f) + 1e-6f);
  const int cnd = cnd_of(row);
  const float* sh = modl + cnd * 6144 + shc * 1024; const float* sc = modl + cnd * 6144 + scc * 1024;
#pragma unroll
  for (int i = 0; i < 4; i++) {
    const int c = (lane + 64 * i) * 4;
    float4 gg = *(const float4*)(g + c), s1 = *(const float4*)(sc + c), s0 = *(const float4*)(sh + c);
    u32x2 o = {f2bf2(v[i].x * rs * gg.x * (1.f + s1.x) + s0.x, v[i].y * rs * gg.y * (1.f + s1.y) + s0.y),
               f2bf2(v[i].z * rs * gg.z * (1.f + s1.z) + s0.z, v[i].w * rs * gg.w * (1.f + s1.w) + s0.w)};
    *(u32x2*)(p.H + (size_t)row * 1024 + c) = o;
  }
}
__device__ void phase_norm(const Params& p, const float* g, const float* modl, int shc, int scc) {
  const int lane = ltid() & 63, w = ltid() >> 6;
  const int stride = vgrid() * 4;
  for (int row = lbid() * 4 + w; row < 8192; row += 2 * stride) {
    const int rowb = row + stride; const bool hb = rowb < 8192;
    const float4* xa = (const float4*)(p.X + (size_t)row * 1024);
    const float4* xb = (const float4*)(p.X + (size_t)(hb ? rowb : row) * 1024);
    float4 va[4], vb[4]; float sa = 0.f, sb = 0.f;
#pragma unroll
    for (int i = 0; i < 4; i++) { va[i] = xa[lane + 64 * i]; vb[i] = xb[lane + 64 * i]; }
#pragma unroll
    for (int i = 0; i < 4; i++) {
      sa += va[i].x * va[i].x + va[i].y * va[i].y + va[i].z * va[i].z + va[i].w * va[i].w;
      sb += vb[i].x * vb[i].x + vb[i].y * vb[i].y + vb[i].z * vb[i].z + vb[i].w * vb[i].w;
    }
    sa = wsum_fast(sa); sb = wsum_fast(sb);
    norm_out(p, row, va, sa, lane, g, modl, shc, scc);
    if (hb) norm_out(p, rowb, vb, sb, lane, g, modl, shc, scc);
  }
}

__device__ __forceinline__ void final_out(const Params& p, int row, const float4 (&v)[4], float ss, int lane, const float* g) {
  const float rs = rsqrtf(ss * (1.f / 1024.f) + 1e-6f);
#pragma unroll
  for (int i = 0; i < 4; i++) {
    const int c = (lane + 64 * i) * 4;
    float4 gg = *(const float4*)(g + c);
    float4 o = {v[i].x * rs * gg.x, v[i].y * rs * gg.y, v[i].z * rs * gg.z, v[i].w * rs * gg.w};
    *(float4*)(p.out + (size_t)row * 1024 + c) = o;
  }
}
__device__ void phase_final(const Params& p) {
  const int lane = ltid() & 63, w = ltid() >> 6;
  const float* g = p.in[I_FG];
  const int stride = vgrid() * 4;
  for (int row = lbid() * 4 + w; row < 8192; row += 2 * stride) {
    const int rowb = row + stride; const bool hb = rowb < 8192;
    const float4* xa = (const float4*)(p.X + (size_t)row * 1024);
    const float4* xb = (const float4*)(p.X + (size_t)(hb ? rowb : row) * 1024);
    float4 va[4], vb[4]; float sa = 0.f, sb = 0.f;
#pragma unroll
    for (int i = 0; i < 4; i++) { va[i] = xa[lane + 64 * i]; vb[i] = xb[lane + 64 * i]; }
#pragma unroll
    for (int i = 0; i < 4; i++) {
      sa += va[i].x * va[i].x + va[i].y * va[i].y + va[i].z * va[i].z + va[i].w * va[i].w;
      sb += vb[i].x * vb[i].x + vb[i].y * vb[i].y + vb[i].z * vb[i].z + vb[i].w * vb[i].w;
    }
    sa = wsum_fast(sa); sb = wsum_fast(sb);
    final_out(p, row, va, sa, lane, g);
    if (hb) final_out(p, rowb, vb, sb, lane, g);
  }
}

__device__ void cache_conv(const Params& p, int i) {
  const int gtid = lbid() * NT + ltid(), gsz = vgrid() * NT;
#pragma unroll 4
  for (int idx = gtid; idx < 2 * 8 * 2 * 512 * 32; idx += gsz) {
    int e = idx & 16383, bhm = idx >> 14;
    int b = bhm >> 4, hm = bhm & 15;
    float v = p.in[I_CK][((size_t)((b * 2 + i) * 16 + hm)) * 16384 + e];
    p.kb_ii[(size_t)bhm * 2560 * 32 + e] = f2bf(v);
  }
#pragma unroll 4
  for (int idx = gtid; idx < 2 * 8 * 512 * 64; idx += gsz) {
    int dv = idx & 63, key = (idx >> 6) & 511, bh = idx >> 15;
    int b = bh >> 3, h = bh & 7;
    float v = p.in[I_CV][((size_t)((b * 2 + i) * 8 + h) * 512 + key) * 64 + dv];
    p.vt_ii[((size_t)bh * 64 + dv) * 2560 + key] = f2bf(v);
  }
}

__device__ void phase_prep(const Params& p, int i) {
  const int tid = ltid();
  const float* mu = p.in[I_MU] + (size_t)i * 2 * 1792;
  const int f = 1536 + tid;
  const float m0 = mu[f], m1 = mu[1792 + f];
  const int vg = vgrid();
  for (int tok0 = lbid(); tok0 < 8192; tok0 += 8 * vg) {
    float cur[8], prev[8], nxt[8];
#pragma unroll
    for (int k = 0; k < 8; k++) {
      const int tok = tok0 + k * vg;
      cur[k] = 0.f; prev[k] = 0.f; nxt[k] = 0.f;
      if (tok < 8192) {
        int t, L;
        if (tok < 4096) { t = tok & 255; L = 256; } else { t = (tok - 4096) & 2047; L = 2048; }
        const float* rp = p.rw + (size_t)tok * 1792 + f;
        cur[k] = rp[0];
        if (t > 0) prev[k] = rp[-1792];
        if (t < L - 1) nxt[k] = rp[1792];
      }
    }
#pragma unroll
    for (int k = 0; k < 8; k++) {
      const int tok = tok0 + k * vg;
      if (tok < 8192) {
        const float v = cur[k] + m0 * (prev[k] - cur[k]) + m1 * (nxt[k] - cur[k]);
        float o;
        if (tid < 64) o = tanhf(v); else if (tid < 128) o = v; else o = sigm(v);
        p.la[(size_t)tok * 256 + tid] = f2bf(o);
      }
    }
  }
}

struct ScanRaw { float cr[4], ck[4], cv[4], pr[4], pk[4], pv[4], nr[4], nk[4], nv[4], dec[4], a[4]; };

__device__ void scan_unit(const Params& p, int i, int grp, int seq, int h, int dir, int chunk, int kind, char* smem) {
  constexpr int BUF = 6 * 1024 + 32;
  float* sbase = (float*)smem;
  const int tid = ltid(), lane = tid & 63, w = tid >> 6;
  const int rp = tid >> 3, q = tid & 7, v0 = 2 * rp;
  const int L = grp ? 2048 : 256;
  const int tokbase = grp ? 4096 + seq * 2048 : seq * 256;
  const int c = h * 64 + lane;
  const float* mu = p.in[I_MU] + (size_t)i * 2 * 1792;
  const float mr0 = mu[c], mr1 = mu[1792 + c], mk0 = mu[512 + c], mk1 = mu[1792 + 512 + c], mv0 = mu[1024 + c], mv1 = mu[1792 + 1024 + c];
  const float kkw = p.in[I_KK][i * 512 + c], kaw = p.in[I_KA][i * 512 + c], rkw = p.in[I_RK][i * 512 + c];
  f32x2 S0[4], S1[4];
#pragma unroll
  for (int e = 0; e < 4; e++) {
    S0[e].x = (kind == 1 && v0 == q * 8 + 2 * e) ? 1.f : 0.f; S0[e].y = (kind == 1 && v0 == q * 8 + 2 * e + 1) ? 1.f : 0.f;
    S1[e].x = (kind == 1 && v0 + 1 == q * 8 + 2 * e) ? 1.f : 0.f; S1[e].y = (kind == 1 && v0 + 1 == q * 8 + 2 * e + 1) ? 1.f : 0.f;
  }
  ScanRaw R;
  auto stage_load = [&](int sc) {
#pragma unroll
    for (int jj = 0; jj < 4; jj++) {
      const int j = w + 4 * jj;
      const int ps = chunk * 256 + sc * 16 + j;
      const int t = dir ? L - 1 - ps : ps;
      const float* rp = p.rw + (size_t)(tokbase + t) * 1792 + c;
      const bool hp = t > 0, hn = t < L - 1;
      R.cr[jj] = rp[0]; R.ck[jj] = rp[512]; R.cv[jj] = rp[1024];
      R.pr[jj] = hp ? rp[-1792] : 0.f; R.pk[jj] = hp ? rp[-1792 + 512] : 0.f; R.pv[jj] = hp ? rp[-1792 + 1024] : 0.f;
      R.nr[jj] = hn ? rp[1792] : 0.f; R.nk[jj] = hn ? rp[1792 + 512] : 0.f; R.nv[jj] = hn ? rp[1792 + 1024] : 0.f;
      R.dec[jj] = p.dec[(size_t)(tokbase + t) * 1024 + dir * 512 + c];
      R.a[jj] = p.aa[(size_t)(tokbase + t) * 1024 + dir * 512 + c];
    }
  };
  auto stage_finish = [&](float* sb) {
#pragma unroll
    for (int jj = 0; jj < 4; jj++) {
      const int j = w + 4 * jj;
      const float rs = R.cr[jj] + mr0 * (R.pr[jj] - R.cr[jj]) + mr1 * (R.nr[jj] - R.cr[jj]);
      const float ks = R.ck[jj] + mk0 * (R.pk[jj] - R.ck[jj]) + mk1 * (R.nk[jj] - R.ck[jj]);
      const float vs = R.cv[jj] + mv0 * (R.pv[jj] - R.cv[jj]) + mv1 * (R.nv[jj] - R.cv[jj]);
      const float dec = R.dec[jj], a = R.a[jj];
      const float kkr = ks * kkw;
      const float ss = wsum_fast(kkr * kkr);
      const float kk = kkr / fmaxf(sqrtf(ss), 1e-12f);
      const float kd = ks * (1.f + (a - 1.f) * kaw);
      const float bb = kk * a;
      const float bon = wsum_fast(rs * kd * rkw);
      const float br = wsum_fast(bb * rs);
      const float kr = wsum_fast(kd * rs);
      sb[j * 64 + lane] = dec; sb[1024 + j * 64 + lane] = -kk; sb[2048 + j * 64 + lane] = bb; sb[3072 + j * 64 + lane] = kd;
      sb[4096 + j * 64 + lane] = dec * rs; sb[5120 + j * 64 + lane] = kind ? 0.f : vs;
      if (lane == 0) { sb[6144 + j] = br; sb[6160 + j] = kr + bon; }
    }
  };
  stage_load(0);
  __syncthreads();
  stage_finish(sbase);
  __syncthreads();
  for (int sc = 0; sc < 16; sc++) {
    const float* sb = sbase + (sc & 1) * BUF;
    if (sc + 1 < 16) stage_load(sc + 1);
    f32x2 nq[4], rq[4];
    {
      const f32x2* n2 = (const f32x2*)(sb + 1024 + q * 8); const f32x2* r2 = (const f32x2*)(sb + 4096 + q * 8);
#pragma unroll
      for (int e = 0; e < 4; e++) { nq[e] = n2[e]; rq[e] = r2[e]; }
    }
#pragma unroll 2
    for (int j = 0; j < 16; j++) {
      const int ps = chunk * 256 + sc * 16 + j;
      const int t = dir ? L - 1 - ps : ps;
      const int tok = tokbase + t;
      const int jn = (j + 1) & 15;
      const f32x2* w2 = (const f32x2*)(sb + j * 64 + q * 8);
      const f32x2* n2x = (const f32x2*)(sb + 1024 + jn * 64 + q * 8);
      const f32x2* b2 = (const f32x2*)(sb + 2048 + j * 64 + q * 8);
      const f32x2* k2 = (const f32x2*)(sb + 3072 + j * 64 + q * 8);
      const f32x2* r2x = (const f32x2*)(sb + 4096 + jn * 64 + q * 8);
      const f32x2 vvp = *(const f32x2*)(sb + 5120 + j * 64 + v0);
      const float br = sb[6144 + j], c2 = sb[6160 + j];
      f32x2 nx[4], rx[4];
#pragma unroll
      for (int e = 0; e < 4; e++) { nx[e] = n2x[e]; rx[e] = r2x[e]; }
      f32x2 sa0 = {0.f, 0.f}, y0 = {0.f, 0.f}, sa1 = {0.f, 0.f}, y1 = {0.f, 0.f};
#pragma unroll
      for (int e = 0; e < 4; e++) { const f32x2 nn = nq[e], rr = rq[e]; sa0 += S0[e] * nn; y0 += S0[e] * rr; sa1 += S1[e] * nn; y1 += S1[e] * rr; }
#pragma unroll
      for (int e = 0; e < 4; e++) { nq[e] = nx[e]; rq[e] = rx[e]; }
      float a0 = sa0.x + sa0.y, a1 = sa1.x + sa1.y, z0 = y0.x + y0.y, z1 = y1.x + y1.y;
      a0 = DPP_ADD(a0, 0xB1); a1 = DPP_ADD(a1, 0xB1); z0 = DPP_ADD(z0, 0xB1); z1 = DPP_ADD(z1, 0xB1);
      a0 = DPP_ADD(a0, 0x4E); a1 = DPP_ADD(a1, 0x4E); z0 = DPP_ADD(z0, 0x4E); z1 = DPP_ADD(z1, 0x4E);
      a0 = DPP_ADD(a0, 0x141); a1 = DPP_ADD(a1, 0x141); z0 = DPP_ADD(z0, 0x141); z1 = DPP_ADD(z1, 0x141);
      const f32x2 sav0 = {a0, a0}, sav1 = {a1, a1}, vv0 = {vvp.x, vvp.x}, vv1 = {vvp.y, vvp.y};
#pragma unroll
      for (int e = 0; e < 4; e++) {
        const f32x2 ww = w2[e], bb = b2[e], kk = k2[e];
        S0[e] = S0[e] * ww + sav0 * bb + vv0 * kk;
        S1[e] = S1[e] * ww + sav1 * bb + vv1 * kk;
      }
      if (q == 0) {
        f32x2 yo = {z0 + a0 * br + vvp.x * c2, z1 + a1 * br + vvp.y * c2};
        if (kind == 0) *(f32x2*)(p.yl + ((size_t)dir * 8192 + tok) * 512 + h * 64 + v0) = yo;
        else *(f32x2*)(p.zb + ((size_t)dir * 4096 + (tok - 4096)) * 512 + h * 64 + v0) = yo;
      }
    }
    if (sc + 1 < 16) stage_finish(sbase + ((sc + 1) & 1) * BUF);
    asm volatile("s_waitcnt lgkmcnt(0)\n\ts_barrier" ::: "memory");
  }
  float* dst;
  if (grp == 0) dst = p.out + (dir ? 17825792 : 16777216) + ((size_t)((seq * 2 + i) * 8 + h)) * 4096;
  else {
    const int u = ((seq * 8 + h) * 2 + dir) * 8 + chunk;
    dst = (kind ? p.pt : p.sl) + (size_t)u * 4096;
  }
#pragma unroll
  for (int e = 0; e < 2; e++) {
    *(float4*)(dst + v0 * 64 + q * 8 + 4 * e) = make_float4(S0[2 * e].x, S0[2 * e].y, S0[2 * e + 1].x, S0[2 * e + 1].y);
    *(float4*)(dst + (v0 + 1) * 64 + q * 8 + 4 * e) = make_float4(S1[2 * e].x, S1[2 * e].y, S1[2 * e + 1].x, S1[2 * e + 1].y);
  }
}

__device__ void scan_unit2(const Params& p, int i, int seq, int h, int dir, int chunk, char* smem) {
  const int grp = 1; const int kind = 0;
  constexpr int BUF = 6 * 1024 + 32;
  float* sbase = (float*)smem;
  const int tid = ltid(), lane = tid & 63, w = tid >> 6;
  const int v = tid >> 2, q = tid & 3;
  const int L = grp ? 2048 : 256;
  const int tokbase = grp ? 4096 + seq * 2048 : seq * 256;
  const int c = h * 64 + lane;
  const float* mu = p.in[I_MU] + (size_t)i * 2 * 1792;
  const float mr0 = mu[c], mr1 = mu[1792 + c], mk0 = mu[512 + c], mk1 = mu[1792 + 512 + c], mv0 = mu[1024 + c], mv1 = mu[1792 + 1024 + c];
  const float kkw = p.in[I_KK][i * 512 + c], kaw = p.in[I_KA][i * 512 + c], rkw = p.in[I_RK][i * 512 + c];
  f32x2 S2[8], P2[8];
#pragma unroll
  for (int e = 0; e < 8; e++) { S2[e].x = 0.f; S2[e].y = 0.f; P2[e].x = (v == q * 16 + 2 * e) ? 1.f : 0.f; P2[e].y = (v == q * 16 + 2 * e + 1) ? 1.f : 0.f; }
  ScanRaw R;
  auto stage_load = [&](int sc) {
#pragma unroll
    for (int jj = 0; jj < 4; jj++) {
      const int j = w + 4 * jj;
      const int ps = chunk * 256 + sc * 16 + j;
      const int t = dir ? L - 1 - ps : ps;
      const float* rp = p.rw + (size_t)(tokbase + t) * 1792 + c;
      const bool hp = t > 0, hn = t < L - 1;
      R.cr[jj] = rp[0]; R.ck[jj] = rp[512]; R.cv[jj] = rp[1024];
      R.pr[jj] = hp ? rp[-1792] : 0.f; R.pk[jj] = hp ? rp[-1792 + 512] : 0.f; R.pv[jj] = hp ? rp[-1792 + 1024] : 0.f;
      R.nr[jj] = hn ? rp[1792] : 0.f; R.nk[jj] = hn ? rp[1792 + 512] : 0.f; R.nv[jj] = hn ? rp[1792 + 1024] : 0.f;
      R.dec[jj] = p.dec[(size_t)(tokbase + t) * 1024 + dir * 512 + c];
      R.a[jj] = p.aa[(size_t)(tokbase + t) * 1024 + dir * 512 + c];
    }
  };
  auto stage_finish = [&](float* sb) {
#pragma unroll
    for (int jj = 0; jj < 4; jj++) {
      const int j = w + 4 * jj;
      const float rs = R.cr[jj] + mr0 * (R.pr[jj] - R.cr[jj]) + mr1 * (R.nr[jj] - R.cr[jj]);
      const float ks = R.ck[jj] + mk0 * (R.pk[jj] - R.ck[jj]) + mk1 * (R.nk[jj] - R.ck[jj]);
      const float vs = R.cv[jj] + mv0 * (R.pv[jj] - R.cv[jj]) + mv1 * (R.nv[jj] - R.cv[jj]);
      const float dec = R.dec[jj], a = R.a[jj];
      const float kkr = ks * kkw;
      const float ss = wsum_fast(kkr * kkr);
      const float kk = kkr / fmaxf(sqrtf(ss), 1e-12f);
      const float kd = ks * (1.f + (a - 1.f) * kaw);
      const float bb = kk * a;
      const float bon = wsum_fast(rs * kd * rkw);
      const float br = wsum_fast(bb * rs);
      const float kr = wsum_fast(kd * rs);
      sb[j * 64 + lane] = dec; sb[1024 + j * 64 + lane] = -kk; sb[2048 + j * 64 + lane] = bb; sb[3072 + j * 64 + lane] = kd;
      sb[4096 + j * 64 + lane] = dec * rs; sb[5120 + j * 64 + lane] = kind ? 0.f : vs;
      if (lane == 0) { sb[6144 + j] = br; sb[6160 + j] = kr + bon; }
    }
  };
  stage_load(0);
  __syncthreads();
  stage_finish(sbase);
  __syncthreads();
  for (int sc = 0; sc < 16; sc++) {
    const float* sb = sbase + (sc & 1) * BUF;
    if (sc + 1 < 16) stage_load(sc + 1);
    f32x2 nq[8], rq[8];
    {
      const f32x2* n2 = (const f32x2*)(sb + 1024 + q * 16); const f32x2* r2 = (const f32x2*)(sb + 4096 + q * 16);
#pragma unroll
      for (int e = 0; e < 8; e++) { nq[e] = n2[e]; rq[e] = r2[e]; }
    }
#pragma unroll 2
    for (int j = 0; j < 16; j++) {
      const int ps = chunk * 256 + sc * 16 + j;
      const int t = dir ? L - 1 - ps : ps;
      const int tok = tokbase + t;
      const int jn = (j + 1) & 15;
      const f32x2* w2 = (const f32x2*)(sb + j * 64 + q * 16);
      const f32x2* n2x = (const f32x2*)(sb + 1024 + jn * 64 + q * 16);
      const f32x2* b2 = (const f32x2*)(sb + 2048 + j * 64 + q * 16);
      const f32x2* k2 = (const f32x2*)(sb + 3072 + j * 64 + q * 16);
      const f32x2* r2x = (const f32x2*)(sb + 4096 + jn * 64 + q * 16);
      const float vv = sb[5120 + j * 64 + v];
      const float br = sb[6144 + j], c2 = sb[6160 + j];
      f32x2 nx[8], rx[8];
#pragma unroll
      for (int e = 0; e < 8; e++) { nx[e] = n2x[e]; rx[e] = r2x[e]; }
      f32x2 sas = {0.f, 0.f}, ys = {0.f, 0.f}, sap = {0.f, 0.f}, yp = {0.f, 0.f};
#pragma unroll
      for (int e = 0; e < 8; e++) { const f32x2 nn = nq[e], rr = rq[e]; sas += S2[e] * nn; ys += S2[e] * rr; sap += P2[e] * nn; yp += P2[e] * rr; }
#pragma unroll
      for (int e = 0; e < 8; e++) { nq[e] = nx[e]; rq[e] = rx[e]; }
      float a0 = sas.x + sas.y, a1 = sap.x + sap.y, z0 = ys.x + ys.y, z1 = yp.x + yp.y;
      a0 = DPP_ADD(a0, 0xB1); a1 = DPP_ADD(a1, 0xB1); z0 = DPP_ADD(z0, 0xB1); z1 = DPP_ADD(z1, 0xB1);
      a0 = DPP_ADD(a0, 0x4E); a1 = DPP_ADD(a1, 0x4E); z0 = DPP_ADD(z0, 0x4E); z1 = DPP_ADD(z1, 0x4E);
      const f32x2 sav0 = {a0, a0}, sav1 = {a1, a1}, vvv = {vv, vv};
#pragma unroll
      for (int e = 0; e < 8; e++) {
        const f32x2 ww = w2[e], bb = b2[e], kk = k2[e];
        S2[e] = S2[e] * ww + sav0 * bb + vvv * kk;
        P2[e] = P2[e] * ww + sav1 * bb;
      }
      if (q == 0) {
        p.yl[((size_t)dir * 8192 + tok) * 512 + h * 64 + v] = z0 + a0 * br + vv * c2;
        p.zb[((size_t)dir * 4096 + (tok - 4096)) * 512 + h * 64 + v] = z1 + a1 * br;
      }
    }
    if (sc + 1 < 16) stage_finish(sbase + ((sc + 1) & 1) * BUF);
    asm volatile("s_waitcnt lgkmcnt(0)\n\ts_barrier" ::: "memory");
  }
  {
    const int u = ((seq * 8 + h) * 2 + dir) * 8 + chunk;
    float* ds = p.sl + (size_t)u * 4096; float* dp = p.pt + (size_t)u * 4096;
#pragma unroll
    for (int e = 0; e < 4; e++) {
      *(float4*)(ds + v * 64 + q * 16 + 4 * e) = make_float4(S2[2 * e].x, S2[2 * e].y, S2[2 * e + 1].x, S2[2 * e + 1].y);
      *(float4*)(dp + v * 64 + q * 16 + 4 * e) = make_float4(P2[2 * e].x, P2[2 * e].y, P2[2 * e + 1].x, P2[2 * e + 1].y);
    }
  }
}

__device__ void attn_unit(const Params& p, int i, int l, int grp, int seq, int head, int qblk, char* smem) {
  u16* sK = (u16*)smem; u16* sV = sK + 128 * 40;
  const int tid = ltid(), lane = tid & 63, w = tid >> 6, ql = lane & 31, hh = lane >> 5;
  const int Lq = grp ? 2048 : 256, Lk = grp ? 2560 : 256;
  const float scale2 = 0.17677669529663687f * 1.4426950408889634f;
  const float lam_init = 0.8f - 0.6f * __expf(-0.3f * (float)l);
  const float* lv = p.in[I_LAM] + i * 128;
  float d01 = 0.f, d23 = 0.f;
  for (int e = 0; e < 32; e++) { d01 += lv[e] * lv[32 + e]; d23 += lv[64 + e] * lv[96 + e]; }
  const float lam = expf(d01) - expf(d23) + lam_init;
  const int q0 = qblk * 128 + w * 32;
  const u16* VT = (grp ? p.vt_ii : p.vt_i) + (size_t)(seq * 8 + head) * 64 * Lk;
  const int nkt = Lk >> 7;
  f32x16 om0[2];
  f32x16 O[2];
#pragma unroll 1
  for (int m = 0; m < 2; m++) {
    const u16* Q = (grp ? p.qb_ii : p.qb_i) + (size_t)((seq * 8 + head) * 2 + m) * Lq * 32;
    const u16* Kp = (grp ? p.kb_ii : p.kb_i) + (size_t)((seq * 8 + head) * 2 + m) * Lk * 32;
    const bf16x8 qf0 = *(const bf16x8*)(Q + (size_t)(q0 + ql) * 32 + 8 * hh);
    const bf16x8 qf1 = *(const bf16x8*)(Q + (size_t)(q0 + ql) * 32 + 16 + 8 * hh);
#pragma unroll
    for (int r = 0; r < 16; r++) { O[0][r] = 0.f; O[1][r] = 0.f; }
    float mrun = -1e30f, lrun = 0.f;
    u32x4 rk[2], rv[4];
#pragma unroll
    for (int j = 0; j < 2; j++) {
      const int id = tid + 256 * j, key = id >> 2, ch = id & 3;
      rk[j] = *(const u32x4*)(Kp + (size_t)key * 32 + ch * 8);
    }
#pragma unroll
    for (int j = 0; j < 4; j++) {
      const int id = tid + 256 * j, dv = id >> 4, ch = id & 15;
      rv[j] = *(const u32x4*)(VT + (size_t)dv * Lk + ch * 8);
    }
    for (int kt = 0; kt < nkt; kt++) {
      __syncthreads();
#pragma unroll
      for (int j = 0; j < 2; j++) {
        const int id = tid + 256 * j, key = id >> 2, ch = id & 3;
        *(u32x4*)(sK + key * 40 + ch * 8) = rk[j];
      }
#pragma unroll
      for (int j = 0; j < 4; j++) {
        const int id = tid + 256 * j, dv = id >> 4, ch = id & 15;
        u32x2 lo = {rv[j][0], rv[j][1]}, hi = {rv[j][2], rv[j][3]};
        *(u32x2*)(sV + dv * 132 + ch * 8) = lo;
        *(u32x2*)(sV + dv * 132 + ch * 8 + 4) = hi;
      }
      __syncthreads();
      if (kt + 1 < nkt) {
#pragma unroll
        for (int j = 0; j < 2; j++) {
          const int id = tid + 256 * j, key = id >> 2, ch = id & 3;
          rk[j] = *(const u32x4*)(Kp + (size_t)((kt + 1) * 128 + key) * 32 + ch * 8);
        }
#pragma unroll
        for (int j = 0; j < 4; j++) {
          const int id = tid + 256 * j, dv = id >> 4, ch = id & 15;
          rv[j] = *(const u32x4*)(VT + (size_t)dv * Lk + (kt + 1) * 128 + ch * 8);
        }
      }
#pragma unroll 1
      for (int sub = 0; sub < 4; sub++) {
        bf16x8 kf0 = *(const bf16x8*)(sK + (sub * 32 + ql) * 40 + 8 * hh);
        bf16x8 kf1 = *(const bf16x8*)(sK + (sub * 32 + ql) * 40 + 16 + 8 * hh);
        f32x16 st;
#pragma unroll
        for (int r = 0; r < 16; r++) st[r] = 0.f;
        st = __builtin_amdgcn_mfma_f32_32x32x16_bf16(kf0, qf0, st, 0, 0, 0);
        st = __builtin_amdgcn_mfma_f32_32x32x16_bf16(kf1, qf1, st, 0, 0, 0);
        float mx = st[0];
#pragma unroll
        for (int r = 1; r < 16; r++) mx = fmaxf(mx, st[r]);
        mx = fmaxf(mx, __shfl_xor(mx, 32));
        const float mnew = fmaxf(mrun, mx * scale2);
        const float alpha = __builtin_amdgcn_exp2f(mrun - mnew);
        mrun = mnew;
        float psum = 0.f;
        float pe[16];
#pragma unroll
        for (int r = 0; r < 16; r++) { pe[r] = __builtin_amdgcn_exp2f(st[r] * scale2 - mnew); psum += pe[r]; }
        u32x4 pw0 = {f2bf2(pe[0], pe[1]), f2bf2(pe[2], pe[3]), f2bf2(pe[4], pe[5]), f2bf2(pe[6], pe[7])};
        u32x4 pw1 = {f2bf2(pe[8], pe[9]), f2bf2(pe[10], pe[11]), f2bf2(pe[12], pe[13]), f2bf2(pe[14], pe[15])};
        const bf16x8 pb0 = __builtin_bit_cast(bf16x8, pw0), pb1 = __builtin_bit_cast(bf16x8, pw1);
        lrun = lrun * alpha + psum;
        const bool resc = __builtin_amdgcn_ballot_w64(alpha != 1.f) != 0ull;
#pragma unroll
        for (int dvt = 0; dvt < 2; dvt++) {
          const u16* vp = sV + (dvt * 32 + ql) * 132 + sub * 32 + 4 * hh;
          bf16x4 v00 = *(const bf16x4*)(vp), v01 = *(const bf16x4*)(vp + 8), v10 = *(const bf16x4*)(vp + 16), v11 = *(const bf16x4*)(vp + 24);
          bf16x8 vf0 = {v00[0], v00[1], v00[2], v00[3], v01[0], v01[1], v01[2], v01[3]};
          bf16x8 vf1 = {v10[0], v10[1], v10[2], v10[3], v11[0], v11[1], v11[2], v11[3]};
          if (resc) {
#pragma unroll
            for (int r = 0; r < 16; r++) O[dvt][r] *= alpha;
          }
          O[dvt] = __builtin_amdgcn_mfma_f32_32x32x16_bf16(vf0, pb0, O[dvt], 0, 0, 0);
          O[dvt] = __builtin_amdgcn_mfma_f32_32x32x16_bf16(vf1, pb1, O[dvt], 0, 0, 0);
        }
      }
    }
    __syncthreads();
    const float lf = lrun + __shfl_xor(lrun, 32);
    const float inv = 1.f / lf;
    if (m == 0) {
#pragma unroll
      for (int r = 0; r < 16; r++) { om0[0][r] = O[0][r] * inv; om0[1][r] = O[1][r] * inv; }
    } else {
#pragma unroll
      for (int r = 0; r < 16; r++) { O[0][r] = om0[0][r] - lam * O[0][r] * inv; O[1][r] = om0[1][r] - lam * O[1][r] * inv; }
    }
  }
  float ss = 0.f;
#pragma unroll
  for (int r = 0; r < 16; r++) ss += O[0][r] * O[0][r] + O[1][r] * O[1][r];
  ss += __shfl_xor(ss, 32);
  const float rinv = rsqrtf(ss * (1.f / 64.f) + 1e-5f) * (1.f - lam_init);
  const float* sg = p.in[I_SUBG] + i * 64;
  const int tok = (grp ? 4096 + seq * 2048 : seq * 256) + q0 + ql;
#pragma unroll
  for (int dvt = 0; dvt < 2; dvt++)
#pragma unroll
    for (int g4 = 0; g4 < 4; g4++) {
      const int dv = dvt * 32 + 8 * g4 + 4 * hh;
      bf16x4 pk;
#pragma unroll
      for (int e = 0; e < 4; e++) pk[e] = (short)f2bf(O[dvt][g4 * 4 + e] * rinv * sg[dv + e]);
      *(bf16x4*)(p.H + (size_t)tok * 1024 + head * 64 + dv) = pk;
    }
}

__device__ void phase_mix(const Params& p, int i, int l, char* smem) {
  for (int item0 = lbid() - vbi(); item0 < 1024; item0 += vgrid()) {
    const int item = min(item0 + vbi(), 1023);
    if (item < 256) {
      int chunk = item & 7, dir = (item >> 3) & 1, h = (item >> 4) & 7, b = item >> 7;
      scan_unit2(p, i, b, h, dir, chunk, smem);
    } else if (item < 512) {
      int u = item - 256; int dir = u & 1, h = (u >> 1) & 7, seq = u >> 4;
      scan_unit(p, i, 0, seq, h, dir, 0, 0, smem);
    } else if (item < 768) {
      int u = item - 512; int qblk = u & 1, head = (u >> 1) & 7, seq = u >> 4;
      attn_unit(p, i, l, 0, seq, head, qblk, smem);
    } else {
      int u = item - 768; int qblk = u & 15, head = (u >> 4) & 7, b = u >> 7;
      attn_unit(p, i, l, 1, b, head, qblk, smem);
    }
  }
}

__device__ __forceinline__ void gn_store(const Params& p, int i, int tok, int c, float y) {
  float mu = wsum_fast(y) * (1.f / 64.f);
  float d = y - mu;
  float var = wsum_fast(d * d) * (1.f / 64.f);
  float yn = d * rsqrtf(var + 64e-5f);
  float o = (yn * p.in[I_LNG][i * 512 + c] + p.in[I_LNB][i * 512 + c]) * bf2f(p.g[(size_t)tok * 512 + c]);
  p.H[(size_t)tok * 1024 + 512 + c] = f2bf(o);
}

__device__ void phase_fin(const Params& p, int i, char* smem) {
  float* SS = (float*)smem; float* tP = SS + 64 * 65; float* zbuf = tP + 4096; float* ybuf = zbuf + 4096;
  const int tid = ltid(), lane = tid & 63, w = tid >> 6;
  for (int item0 = lbid() - vbi(); item0 < 1024; item0 += vgrid()) {
    const int item = min(item0 + vbi(), 1023);
    if (item < 512) {
      const int qt = item & 3, ct = (item >> 2) & 7, h = (item >> 5) & 7, b = item >> 8;
      const int v = tid >> 2, q = tid & 3;
      float accF[16], accB[16];
#pragma unroll 1
      for (int dirn = 0; dirn < 2; dirn++) {
        const float* s0 = p.in[dirn ? I_SB : I_SF] + ((size_t)((b * 2 + i) * 8 + h)) * 4096;
        float acc[16];
#pragma unroll
        for (int e = 0; e < 16; e++) acc[e] = s0[v * 64 + q * 16 + e];
        const int cEnd = dirn ? 7 - ct : ct;
        const int ub0 = ((b * 8 + h) * 2 + dirn) * 8;
        float pn[16], sn[16];
        if (cEnd > 0) {
#pragma unroll
          for (int e = 0; e < 16; e++) { pn[e] = p.pt[(size_t)ub0 * 4096 + tid + NT * e]; sn[e] = p.sl[(size_t)ub0 * 4096 + v * 64 + q * 16 + e]; }
        }
        for (int cc = 0; cc < cEnd; cc++) {
          __syncthreads();
#pragma unroll
          for (int e = 0; e < 16; e++) SS[v * 65 + q * 16 + e] = acc[e];
#pragma unroll
          for (int e = 0; e < 16; e++) tP[tid + NT * e] = pn[e];
          __syncthreads();
#pragma unroll
          for (int e = 0; e < 16; e++) acc[e] = sn[e];
          if (cc + 1 < cEnd) {
#pragma unroll
            for (int e = 0; e < 16; e++) { pn[e] = p.pt[(size_t)(ub0 + cc + 1) * 4096 + tid + NT * e]; sn[e] = p.sl[(size_t)(ub0 + cc + 1) * 4096 + v * 64 + q * 16 + e]; }
          }
#pragma unroll 4
          for (int k = 0; k < 64; k++) {
            const float sv = SS[v * 65 + k];
            const float4* pr = (const float4*)(tP + k * 64 + q * 16);
#pragma unroll
            for (int e = 0; e < 4; e++) { float4 pv = pr[e]; acc[4 * e] += sv * pv.x; acc[4 * e + 1] += sv * pv.y; acc[4 * e + 2] += sv * pv.z; acc[4 * e + 3] += sv * pv.w; }
          }
        }
        if (dirn == 0) {
#pragma unroll
          for (int e = 0; e < 16; e++) accF[e] = acc[e];
        } else {
#pragma unroll
          for (int e = 0; e < 16; e++) accB[e] = acc[e];
        }
      }
      for (int tb = qt * 64; tb < qt * 64 + 64; tb += 32) {
        const int tokii0 = b * 2048 + ct * 256 + tb;
        __syncthreads();
        for (int e = tid; e < 4096; e += NT) {
          const int dirn = e >> 11, tt = (e >> 6) & 31, k = e & 63;
          zbuf[e] = p.zb[((size_t)dirn * 4096 + tokii0 + tt) * 512 + h * 64 + k];
        }
        __syncthreads();
#pragma unroll 2
        for (int tt = 0; tt < 32; tt++) {
          const float4* zf = (const float4*)(zbuf + tt * 64 + q * 16);
          const float4* zb = (const float4*)(zbuf + 2048 + tt * 64 + q * 16);
          float part = 0.f;
#pragma unroll
          for (int e = 0; e < 4; e++) {
            float4 a = zf[e], c4 = zb[e];
            part += accF[4 * e] * a.x + accF[4 * e + 1] * a.y + accF[4 * e + 2] * a.z + accF[4 * e + 3] * a.w;
            part += accB[4 * e] * c4.x + accB[4 * e + 1] * c4.y + accB[4 * e + 2] * c4.z + accB[4 * e + 3] * c4.w;
          }
          part += __shfl_xor(part, 1); part += __shfl_xor(part, 2);
          if (q == 0) ybuf[tt * 64 + v] = part;
        }
        __syncthreads();
#pragma unroll
        for (int t8 = 0; t8 < 8; t8++) {
          const int tt = w + 4 * t8;
          const int tok = 4096 + tokii0 + tt;
          const int c = h * 64 + lane;
          float y = ybuf[tt * 64 + lane] + p.yl[(size_t)tok * 512 + c] + p.yl[((size_t)8192 + tok) * 512 + c];
          gn_store(p, i, tok, c, y);
        }
      }
      __syncthreads();
    } else {
      const int tb = (item - 512) * 8;
#pragma unroll 8
      for (int w16 = 0; w16 < 16; w16++) {
        const int wi = w + 4 * w16;
        const int tok = tb + (wi >> 3), h = wi & 7, c = h * 64 + lane;
        float y = p.yl[(size_t)tok * 512 + c] + p.yl[((size_t)8192 + tok) * 512 + c];
        gn_store(p, i, tok, c, y);
      }
    }
  }
}

__device__ __forceinline__ float2 cmul(float2 a, float2 b) { return make_float2(a.x * b.x - a.y * b.y, a.x * b.y + a.y * b.x); }

__device__ void fft_dif(float2* x, int npts, int nf) {
  for (int s = nf >> 1; s >= 1; s >>= 1) {
    const float inv2s = 0.5f / (float)s;
    for (int idx = ltid(); idx < (npts >> 1); idx += NT) {
      const int j = idx & (s - 1); const int base = ((idx - j) << 1) + j;
      float2 a = x[base], b = x[base + s];
      const float rev = -(float)j * inv2s;
      const float wr = __builtin_amdgcn_cosf(rev), wi = __builtin_amdgcn_sinf(rev);
      float2 d = make_float2(a.x - b.x, a.y - b.y);
      x[base] = make_float2(a.x + b.x, a.y + b.y);
      x[base + s] = make_float2(d.x * wr - d.y * wi, d.x * wi + d.y * wr);
    }
    __syncthreads();
  }
}
__device__ void fft_dit_inv(float2* x, int npts, int nf) {
  for (int s = 1; s <= (nf >> 1); s <<= 1) {
    const float inv2s = 0.5f / (float)s;
    for (int idx = ltid(); idx < (npts >> 1); idx += NT) {
      const int j = idx & (s - 1); const int base = ((idx - j) << 1) + j;
      float2 a = x[base], b = x[base + s];
      const float rev = -(float)j * inv2s;
      const float wr = __builtin_amdgcn_cosf(rev), wi = __builtin_amdgcn_sinf(rev);
      float2 bb = make_float2(b.x * wr + b.y * wi, b.y * wr - b.x * wi);
      x[base] = make_float2(a.x + bb.x, a.y + bb.y);
      x[base + s] = make_float2(a.x - bb.x, a.y - bb.y);
    }
    __syncthreads();
  }
}

__device__ __forceinline__ float shortc(const float* pr, int m, int L, float w0, float w1, float w2, float b0) {
  return w0 * (m > 0 ? pr[-1] : 0.f) + w1 * pr[0] + w2 * (m < L - 1 ? pr[1] : 0.f) + b0;
}

template <int NF>
__device__ void hyena_item(const Params& p, int jl, int c, char* smem) {
  constexpr int L = NF / 2;
  constexpr int grp = (NF == 4096) ? 1 : 0;
  float2* bufA = (float2*)smem; float2* bufB = bufA + 4096; float* w3c = (float*)(bufB + 4096);
  const int tid = ltid();
  const float* HD = p.hd + (size_t)(jl * 2 + grp) * 2048 * 64;
  float2* u1 = p.u1buf + (size_t)lbid() * 4096;
  w3c[tid] = p.in[I_FW3][(size_t)jl * 64 * 4096 + (size_t)(tid & 63) * 4096 + (tid >> 6) * 1024 + c];
  const float MINd = -3.0701134573253944f, MAXd = -15.350567286626973f;
  const float delta = fabsf(MINd + (MAXd - MINd) * (float)c / 1023.f);
  const float* cw = p.in[I_HYCW] + (size_t)jl * 3 * 3072; const float* cb = p.in[I_HYCB] + (size_t)jl * 3072;
  const int chin = 2048 + c;
  const float vw0 = cw[chin], vw1 = cw[3072 + chin], vw2 = cw[6144 + chin], vb0 = cb[chin];
  const float* PHv = p.pht + (size_t)chin * 8192;
  __syncthreads();
#pragma unroll 1
  for (int o = 0; o < 2; o++) {
    for (int n = tid; n < NF; n += NT) {
      float val = 0.f;
      if (n != L) {
        const int t = n < L ? n : NF - n; const int dirn = n > L ? 1 : 0;
        const float4* hp = (const float4*)(HD + (size_t)t * 64); const float4* wp = (const float4*)(w3c + (o * 2 + dirn) * 64);
        float dot = 0.f;
#pragma unroll 4
        for (int e = 0; e < 16; e++) { float4 a = hp[e], b = wp[e]; dot += a.x * b.x + a.y * b.y + a.z * b.z + a.w * b.w; }
        val = dot * __expf(-((float)t / (float)(L - 1)) * delta);
      }
      bufB[n] = make_float2(val, 0.f);
    }
#pragma unroll 2
    for (int ii = 0; ii < 16; ii++) {
      const int n = tid + NT * ii; const int pair = n / NF, m = n % NF;
      float re = 0.f, im = 0.f;
      if (m < L) {
        if (o == 0) {
          const int tokRe = grp ? 4096 + m : (2 * pair) * 256 + m; const int tokIm = grp ? 6144 + m : (2 * pair + 1) * 256 + m;
          re = shortc(PHv + tokRe, m, L, vw0, vw1, vw2, vb0);
          im = shortc(PHv + tokIm, m, L, vw0, vw1, vw2, vb0);
        } else { float2 t2 = u1[n]; re = t2.x; im = t2.y; }
      }
      bufA[n] = make_float2(re, im);
    }
    __syncthreads();
    fft_dif(bufB, NF, NF);
    fft_dif(bufA, 4096, NF);
#pragma unroll 2
    for (int ii = 0; ii < 16; ii++) { const int n = tid + NT * ii; bufA[n] = cmul(bufA[n], bufB[n % NF]); }
    __syncthreads();
    fft_dit_inv(bufA, 4096, NF);
    const float bias = p.in[I_HYBIAS][(size_t)(jl * 2 + o) * 1024 + c];
    const int chg = (o == 0 ? 0 : 1024) + c;
    const float w0 = cw[chg], w1 = cw[3072 + chg], w2 = cw[6144 + chg], b0 = cb[chg];
    const float* PHg = p.pht + (size_t)chg * 8192;
#pragma unroll 2
    for (int ii = 0; ii < 16; ii++) {
      const int n = tid + NT * ii; const int pair = n / NF, m = n % NF;
      if (m < L) {
        const int tokRe = grp ? 4096 + m : (2 * pair) * 256 + m; const int tokIm = grp ? 6144 + m : (2 * pair + 1) * 256 + m;
        float2 y = bufA[n];
        float ir, iim;
        if (o == 0) { ir = shortc(PHv + tokRe, m, L, vw0, vw1, vw2, vb0); iim = shortc(PHv + tokIm, m, L, vw0, vw1, vw2, vb0); }
        else { float2 t2 = u1[n]; ir = t2.x; iim = t2.y; }
        float yr = y.x * (1.f / NF) + bias * ir, yi = y.y * (1.f / NF) + bias * iim;
        float gr = shortc(PHg + tokRe, m, L, w0, w1, w2, b0);
        float gi = shortc(PHg + tokIm, m, L, w0, w1, w2, b0);
        float ur = gr * yr, ui = gi * yi;
        if (o == 0) { u1[n] = make_float2(ur, ui); }
        else { p.H[(size_t)tokRe * 1024 + c] = f2bf(ur); p.H[(size_t)tokIm * 1024 + c] = f2bf(ui); }
      }
    }
    __syncthreads();
  }
}

__device__ __forceinline__ float shortc_h(const u16* pr, int m, int L, float w0, float w1, float w2, float b0) {
  return w0 * (m > 0 ? bf2f(pr[-1]) : 0.f) + w1 * bf2f(pr[0]) + w2 * (m < L - 1 ? bf2f(pr[1]) : 0.f) + b0;
}

template <int L>
__device__ void hyena_item2(const Params& p, int jl, int c, char* smem) {
  constexpr int NB = L / 32;
  constexpr int GLEN = 2 * L + 32;
  constexpr int SEQS = (3 * NB - 2) * 40;
  constexpr int NSEQ = 4096 / L;
  constexpr int UBLEN = NSEQ * SEQS;
  constexpr int grp = (L == 2048) ? 1 : 0;
  constexpr int poff = grp ? 256 : 0;
  u16* Gc = (u16*)smem; u16* ub = Gc + 4 * GLEN;
  const int tid = ltid(), lane = tid & 63, w = tid >> 6, l31 = lane & 31, hh = lane >> 5;
  const int tokbase = grp ? 4096 : 0;
  const float* cw = p.in[I_HYCW] + (size_t)jl * 3 * 3072; const float* cb = p.in[I_HYCB] + (size_t)jl * 3072;
  constexpr int NG = 2 * L / NT;
  u16 gtap[NG];
  auto load_taps = [&](int o) {
    const u16* FTf = p.ft + ((size_t)((o * 2 + 0) * 1024 + c)) * 2304 + poff;
    const u16* FTb = p.ft + ((size_t)((o * 2 + 1) * 1024 + c)) * 2304 + poff;
#pragma unroll
    for (int k = 0; k < NG; k++) {
      const int y = tid + NT * k;
      u16 gv = 0;
      if (y != 0) { const int x = y - L; gv = x <= 0 ? FTf[-x] : FTb[x]; }
      gtap[k] = gv;
    }
  };
  load_taps(0);
  __syncthreads();
  for (int e = tid; e < UBLEN / 8; e += NT) ((u32x4*)ub)[e] = (u32x4){0u, 0u, 0u, 0u};
  __syncthreads();
  {
    const int chin = 2048 + c;
    const float w0 = cw[chin], w1 = cw[3072 + chin], w2 = cw[6144 + chin], b0 = cb[chin];
    const u16* PHv = (const u16*)p.pht + (size_t)chin * 8192 + tokbase;
#pragma unroll 4
    for (int k = 0; k < 16; k++) {
      const int tk = tid + NT * k; const int sq = tk / L, t = tk % L;
      const float val = shortc_h(PHv + tk, t, L, w0, w1, w2, b0);
      ub[sq * SEQS + (NB - 1 + (t >> 5)) * 40 + (t & 31)] = f2bf(val);
    }
  }
  const int n = 32 * w + l31;
  const int sq = grp ? (n >> 6) : (n >> 3);
  const int a = grp ? (n & 63) : (n & 7);
  const int dlo = grp ? (32 * (w & 1) - 63) : -(NB - 1);
  const int dhi = grp ? (32 * (w & 1) + 31) : (NB - 1);
  const int i4 = l31 >> 2, ir = l31 & 3;
  const u16* Ga = Gc + ir * GLEN + (L - 4 * i4 + 8 * hh);
  const u16* Ba = ub + sq * SEQS + (a + NB - 1) * 40 + 8 * hh;
  float u1r[16];
#pragma unroll 1
  for (int o = 0; o < 2; o++) {
#pragma unroll
    for (int k = 0; k < NG; k++) {
      const int y = tid + NT * k;
#pragma unroll
      for (int r = 0; r < 4; r++) Gc[r * GLEN + y + r] = gtap[k];
    }
    __syncthreads();
    if (o == 0) load_taps(1);
    const int chg = (o == 0 ? 0 : 1024) + c;
    const u16* PHg = (const u16*)p.pht + (size_t)chg * 8192 + tokbase + sq * L;
    float gw[4][6];
#pragma unroll
    for (int g = 0; g < 4; g++)
#pragma unroll
      for (int e = 0; e < 6; e++) { const int tt = 32 * a + 8 * g + 4 * hh - 1 + e; gw[g][e] = (tt >= 0 && tt < L) ? bf2f(PHg[tt]) : 0.f; }
    f32x16 acc0, acc1;
#pragma unroll
    for (int r = 0; r < 16; r++) { acc0[r] = 0.f; acc1[r] = 0.f; }
#pragma unroll 2
    for (int d = dlo; d <= dhi; d++) {
      const u16* ga = Ga - 32 * d;
      const u16* ba = Ba - 40 * d;
      bf16x4 a0 = *(const bf16x4*)(ga), a1 = *(const bf16x4*)(ga + 4), a2 = *(const bf16x4*)(ga + 16), a3 = *(const bf16x4*)(ga + 20);
      bf16x8 af0 = {a0[0], a0[1], a0[2], a0[3], a1[0], a1[1], a1[2], a1[3]};
      bf16x8 af1 = {a2[0], a2[1], a2[2], a2[3], a3[0], a3[1], a3[2], a3[3]};
      bf16x8 bf0 = *(const bf16x8*)(ba), bf1 = *(const bf16x8*)(ba + 16);
      acc0 = __builtin_amdgcn_mfma_f32_32x32x16_bf16(af0, bf0, acc0, 0, 0, 0);
      acc1 = __builtin_amdgcn_mfma_f32_32x32x16_bf16(af1, bf1, acc1, 0, 0, 0);
    }
    const float bias = p.in[I_HYBIAS][(size_t)(jl * 2 + o) * 1024 + c];
    const float w0 = cw[chg], w1 = cw[3072 + chg], w2 = cw[6144 + chg], b0 = cb[chg];
    __syncthreads();
#pragma unroll
    for (int r = 0; r < 16; r++) {
      const int ii = ACC_ROW(r, hh);
      const int t = 32 * a + ii;
      const int ui = sq * SEQS + (a + NB - 1) * 40 + ii;
      const float uin = (o == 0) ? bf2f(ub[ui]) : u1r[r];
      const float y = acc0[r] + acc1[r] + bias * uin;
      const float gate = w0 * gw[r >> 2][r & 3] + w1 * gw[r >> 2][(r & 3) + 1] + w2 * gw[r >> 2][(r & 3) + 2] + b0;
      const float uo = gate * y;
      if (o == 0) { u1r[r] = uo; ub[ui] = f2bf(uo); }
      else p.H[(size_t)(tokbase + sq * L + t) * 1024 + c] = f2bf(uo);
    }
    __syncthreads();
  }
}

__device__ void phase_hyena(const Params& p, int jl, char* smem) {
  for (int item0 = lbid() - vbi(); item0 < 2048; item0 += vgrid()) {
    const int item = min(item0 + vbi(), 2047);
    if (item < 1024) hyena_item2<2048>(p, jl, item, smem);
    else hyena_item2<256>(p, jl, item - 1024, smem);
  }
}

__device__ void run_phase(const Params& p, int ph, char* smem, char* gsm) {
  if (ph == 0) { phase0(p, smem); return; }
  if (ph == 1) { phase1(p, smem); return; }
  int q = ph - 2, l;
  if (q < 10) l = 0; else if (q < 17) { l = 1; q -= 10; } else if (q < 27) { l = 2; q -= 17; } else if (q < 34) { l = 3; q -= 27; } else { phase_final(p); return; }
  const float* modl = p.mod + (size_t)l * 18432;
  const int i = l >> 1;
  int fq;
  if ((l & 1) == 0) {
    switch (q) {
      case 0: phase_norm(p, p.in[I_N1G] + l * 1024, modl, 0, 1); cache_conv(p, i); return;
      case 1: { EpiAbIn e{p, i}; gemm8<2>(p.H, p.wt_abin + (size_t)i * 3328 * 1024, 8192, 3328, 1024, e, gsm); return; }
      case 2: phase_prep(p, i); return;
      case 3: { EpiLora e{p, i}; gemm8<2, EpiLora, true>(p.la, p.wt_lora + (size_t)i * 2560 * 256, 8192, 2560, 256, e, gsm); return; }
      case 4: phase_mix(p, i, l, smem); return;
      case 5: phase_fin(p, i, smem); return;
      case 6: { EpiResid e{p.X, modl + 2 * 1024, nullptr}; gemm8<2>(p.H, p.wt_about + (size_t)i * 1024 * 1024, 8192, 1024, 1024, e, gsm); return; }
      default: fq = q - 7;
    }
  } else {
    switch (q) {
      case 0: phase_norm(p, p.in[I_N1G] + l * 1024, modl, 0, 1); return;
      case 1: { EpiHyIn e{(u16*)p.pht, p.in[I_HYBIN] + i * 3072}; gemm8<2>(p.wt_hyin + (size_t)i * 3072 * 1024, p.H, 3072, 8192, 1024, e, gsm);
                EpiFilt ef{p.ft}; gemm(p.w3t + (size_t)i * 4096 * 64, p.hdb + (size_t)i * 2304 * 64, 4096, 2304, 64, ef, smem); return; }
      case 2: phase_hyena(p, i, smem); return;
      case 3: { EpiResid e{p.X, modl + 2 * 1024, p.in[I_HYBOUT] + i * 1024}; gemm8<2>(p.H, p.wt_hyout + (size_t)i * 1024 * 1024, 8192, 1024, 1024, e, gsm); return; }
      default: fq = q - 4;
    }
  }
  if (fq == 0) { phase_norm(p, p.in[I_N2G] + l * 1024, modl, 3, 4); return; }
  if (fq == 1) { EpiSwiglu e{p.act}; gemm8<4>(p.H, p.wt_13 + (size_t)l * 5632 * 1024, 8192, 5632, 1024, e, gsm); return; }
  { EpiResid e{p.X, modl + 5 * 1024, nullptr}; gemm8<2>(p.act, p.wt_2 + (size_t)l * 1024 * 2816, 8192, 1024, 2816, e, gsm); }
}

#define XB_TMO      128
#define XB_XCNT(j)  (256  + 64 * (j))
#define XB_XSUB(j)  (1280 + 64 * (j))
#define XB_XGEN(j)  (2304 + 64 * (j))
#define XB_TOP      3328
#define XB_TOPGEN   3392
#define XCD_BAR_WORDS 3456
#define XB_SPIN_CAP (1u << 18)
#define LAS __attribute__((address_space(3)))

__device__ __forceinline__ unsigned xb_ld(unsigned* p)              { return __hip_atomic_load(p, __ATOMIC_RELAXED, __HIP_MEMORY_SCOPE_AGENT); }
__device__ __forceinline__ unsigned xb_add(unsigned* p, unsigned v) { return __hip_atomic_fetch_add(p, v, __ATOMIC_RELAXED, __HIP_MEMORY_SCOPE_AGENT); }
__device__ __forceinline__ unsigned xb_xcc_id() { return (unsigned)__builtin_amdgcn_s_getreg((3 << 11) | 20) & 0xFu; }
#define XB_SPIN(cond, bar) do { unsigned _sp = 0; while (cond) { __builtin_amdgcn_s_sleep(1); \
    if ((++_sp & 255u) == 0u) { if (xb_ld(&(bar)[XB_TMO])) break; if (_sp > XB_SPIN_CAP) { atomicAdd(&(bar)[XB_TMO], 1u); break; } } } } while (0)

struct XcdBarrier {
    unsigned* bar; unsigned x;
    volatile LAS unsigned* st;
};

__device__ __forceinline__ XcdBarrier xcd_barrier_post(unsigned* bar, volatile LAS unsigned* st) {
    XcdBarrier b; b.bar = bar; b.x = xb_xcc_id(); b.st = st;
    if (threadIdx.x == 0) (void)xb_add(&bar[XB_XCNT(b.x)], 1u);
    return b;
}
__device__ __forceinline__ void xcd_barrier_complete(unsigned* bar, unsigned x, unsigned& nloc, unsigned& nx) {
    const unsigned G = gridDim.x * gridDim.y * gridDim.z;
    unsigned sum, cnt, mine, sp = 0u;
    for (;;) {
        sum = 0u; cnt = 0u; mine = 0u;
#pragma unroll
        for (unsigned j = 0; j < 16; ++j) { const unsigned c = xb_ld(&bar[XB_XCNT(j)]); sum += c; cnt += (c > 0u) ? 1u : 0u; mine = (j == x) ? c : mine; }
        if (sum == G) break;
        __builtin_amdgcn_s_sleep(1);
        if ((++sp & 255u) == 0u) { if (xb_ld(&bar[XB_TMO])) break; if (sp > XB_SPIN_CAP) { atomicAdd(&bar[XB_TMO], 1u); break; } }
    }
    nloc = mine > 0u ? mine : 1u; nx = cnt > 0u ? cnt : 1u;
}

__device__ __forceinline__ void xcd_barrier(const XcdBarrier& b) {
    asm volatile("s_waitcnt vmcnt(0)" ::: "memory");
    __syncthreads();
    if (threadIdx.x == 0) {
        unsigned* bar = b.bar;
        __builtin_amdgcn_s_waitcnt(0);
        unsigned nloc = b.st[0], nx = b.st[1];
        if (nloc == 0u) { xcd_barrier_complete(bar, b.x, nloc, nx); b.st[0] = nloc; b.st[1] = nx; }
        const unsigned old = xb_add(&bar[XB_XSUB(b.x)], 1u);
        const unsigned gen = old / nloc;
        if (old + 1u == (gen + 1u) * nloc) {
            __builtin_amdgcn_fence(__ATOMIC_RELEASE, "agent");
            asm volatile("s_waitcnt vmcnt(0)" ::: "memory");
            const unsigned og = xb_add(&bar[XB_TOP], 1u);
            const unsigned tg = og / nx;
            if (og + 1u == (tg + 1u) * nx) xb_add(&bar[XB_TOPGEN], 1u);
            else XB_SPIN(xb_ld(&bar[XB_TOPGEN]) == tg, bar);
            __builtin_amdgcn_fence(__ATOMIC_ACQUIRE, "agent");
            xb_add(&bar[XB_XGEN(b.x)], 1u);
            asm volatile("s_waitcnt vmcnt(0)" ::: "memory");
        } else {
            XB_SPIN(xb_ld(&bar[XB_XGEN(b.x)]) == gen, bar);
            __builtin_amdgcn_fence(__ATOMIC_ACQUIRE, "agent");
            asm volatile("s_waitcnt vmcnt(0)" ::: "memory");
        }
    }
    __syncthreads();
}


__global__ void __launch_bounds__(512, 2) mega(Params p, int lo, int hi) {
  extern __shared__ __attribute__((aligned(16))) char smem[];
  __shared__ uint4 xb_words;
  cg::grid_group grid = cg::this_grid();
  if (threadIdx.x == 0) xb_words = make_uint4(0u, 0u, 0u, 0u);
  __syncthreads();
  XcdBarrier xb = xcd_barrier_post(p.bar, (volatile LAS unsigned*)&xb_words);
  for (int ph = lo; ph < hi; ph++) {
    run_phase(p, ph, smem + (size_t)vbi() * LDS_BYTES, smem);
    if (ph + 1 < hi) {
      if (ph == lo) grid.sync();
      else xcd_barrier(xb);
    }
  }
}

extern "C" void kernel_launch(void* const* d_in, const int* in_sizes, int n_in, void* d_out, int out_size, void* d_ws, size_t ws_size, hipStream_t stream) {
  static int grid_blocks = 0;
  if (!grid_blocks) {
    int dev = 0, cus = 0, per_cu = 0;
    hipGetDevice(&dev);
    hipDeviceGetAttribute(&cus, hipDeviceAttributeMultiprocessorCount, dev);
    hipFuncSetAttribute((const void*)mega, hipFuncAttributeMaxDynamicSharedMemorySize, 2 * LDS_BYTES);
    hipOccupancyMaxActiveBlocksPerMultiprocessor(&per_cu, mega, 512, 2 * LDS_BYTES);
    if (per_cu > 1) per_cu = 1;
    if (per_cu < 1) per_cu = 1;
    grid_blocks = cus * per_cu;
  }
  Params p;
  memset(&p, 0, sizeof(p));
  for (int i = 0; i < 46; i++) p.in[i] = (const float*)d_in[i];
  p.out = (float*)d_out;
  char* ws = (char*)d_ws; size_t off = 0;
  auto alloc = [&](size_t bytes) { char* r = ws + off; off += (bytes + 255) & ~(size_t)255; return r; };
  p.wt_abin = (u16*)alloc((size_t)2 * 3328 * 1024 * 2);
  p.wt_about = (u16*)alloc((size_t)2 * 1024 * 1024 * 2);
  p.wt_lora = (u16*)alloc((size_t)2 * 2560 * 256 * 2);
  p.wt_hyin = (u16*)alloc((size_t)2 * 3072 * 1024 * 2);
  p.wt_hyout = (u16*)alloc((size_t)2 * 1024 * 1024 * 2);
  p.wt_13 = (u16*)alloc((size_t)4 * 5632 * 1024 * 2);
  p.wt_2 = (u16*)alloc((size_t)4 * 1024 * 2816 * 2);
  p.X = (float*)alloc((size_t)8192 * 1024 * 4);
  p.H = (u16*)alloc((size_t)8192 * 1024 * 2);
  p.modp = (float*)alloc((size_t)16 * 4 * 3 * 6144 * 4);
  p.mod = (float*)alloc((size_t)4 * 3 * 6144 * 4);
  p.hd = (float*)alloc((size_t)2 * 2 * 2048 * 64 * 4);
  p.rope = (float*)alloc((size_t)2048 * 16 * 2 * 4);
  p.bar = (unsigned*)alloc(16384);
  p.hdb = (u16*)alloc((size_t)2 * 2304 * 64 * 2);
  p.w3t = (u16*)alloc((size_t)2 * 4096 * 64 * 2);
  const size_t arena = off;
  p.qb_i = (u16*)alloc((size_t)4096 * 512 * 2);
  p.qb_ii = (u16*)alloc((size_t)4096 * 512 * 2);
  p.kb_i = (u16*)alloc((size_t)4096 * 512 * 2);
  p.kb_ii = (u16*)alloc((size_t)2 * 8 * 2 * 2560 * 32 * 2);
  p.vt_i = (u16*)alloc((size_t)4096 * 512 * 2);
  p.vt_ii = (u16*)alloc((size_t)2 * 8 * 64 * 2560 * 2);
  p.rw = (float*)alloc((size_t)8192 * 1792 * 4);
  p.la = (u16*)alloc((size_t)8192 * 256 * 2);
  p.dec = (float*)alloc((size_t)8192 * 1024 * 4);
  p.aa = (float*)alloc((size_t)8192 * 1024 * 4);
  p.g = (u16*)alloc((size_t)8192 * 512 * 2);
  p.yl = (float*)alloc((size_t)2 * 8192 * 512 * 4);
  p.zb = (float*)alloc((size_t)2 * 4096 * 512 * 4);
  p.sl = (float*)alloc((size_t)256 * 4096 * 4);
  p.pt = (float*)alloc((size_t)256 * 4096 * 4);
  const size_t total = off;
  p.pht = (float*)(ws + arena);
  p.u1buf = (float2*)(ws + arena + (size_t)3072 * 8192 * 4);
  p.ft = (u16*)(ws + arena + (size_t)3072 * 8192 * 4);
  p.act = (u16*)(ws + arena);
  if (total > ws_size) { fprintf(stderr, "workspace too small: need %zu have %zu\n", total, ws_size); return; }
#if MULTI
  for (int ph = 0; ph < NPHASE; ph++) {
    hipLaunchKernelGGL(mega, dim3(grid_blocks), dim3(512), 2 * LDS_BYTES, stream, p, ph, ph + 1);
  }
#else
  hipMemsetAsync(p.bar, 0, 16384, stream);
  int lo = 0, hi = NPHASE;
  void* args[] = {&p, &lo, &hi};
  hipError_t e = hipLaunchCooperativeKernel((void*)mega, dim3(grid_blocks), dim3(512), args, 2 * LDS_BYTES, stream);
  if (e != hipSuccess) fprintf(stderr, "cooperative launch failed: %s (grid %d)\n", hipGetErrorString(e), grid_blocks);
#endif
}
```
